# Optimizing an MI355X kernel written in HIP

```python
import jax, jax.numpy as jnp
from jax import lax
import numpy as np

D_MODEL = 2048
BATCH = 8
SEQ = 2048
DEPTH = 4

CHUNK = 64
MIX_WIDTH = D_MODEL
GROUP_WIDTH = MIX_WIDTH // 4
CONV_K = 3
SB_HEADS = 4
SB_HEAD_DIM = GROUP_WIDTH // SB_HEADS
SB_BLOCK = 128
GLA_HEADS = 4
GLA_DV = GROUP_WIDTH // GLA_HEADS
GLA_DK = GLA_DV // 2
GLA_GATE_RANK = 16
GLA_TAU = 16.0
POOL_WINDOWS = (2, 4, 8, 16)
POOL_GROUP = GROUP_WIDTH // len(POOL_WINDOWS)
D_FF = -((-8 * D_MODEL) // (3 * 256)) * 256
RMS_EPS = 1e-6

IN_SPLIT_SIZES = (GROUP_WIDTH, GROUP_WIDTH, GROUP_WIDTH,
                  GROUP_WIDTH, GROUP_WIDTH, GROUP_WIDTH,
                  GLA_HEADS * GLA_DK, GLA_HEADS * GLA_DK, GROUP_WIDTH, GROUP_WIDTH, GLA_GATE_RANK,
                  GROUP_WIDTH)
IN_COLS = sum(IN_SPLIT_SIZES)
IN_SPLIT_POINTS = tuple(int(v) for v in np.cumsum(IN_SPLIT_SIZES)[:-1])

kernel_name = 'hybrid_parallel_conv_stickbreak_gla_pool_block'


def rms_norm(x, g):
    xf = x.astype(jnp.float32)
    y = xf * lax.rsqrt(jnp.mean(xf * xf, axis=-1, keepdims=True) + RMS_EPS)
    return (y * g.astype(jnp.float32)).astype(x.dtype)


def short_conv_mixer(b, c, h, conv_w):
    S = h.shape[1]
    u = jnp.pad(c * h, ((0, 0), (CONV_K - 1, 0), (0, 0)))
    y = conv_w[0] * u[:, 0:S]
    for i in range(1, CONV_K):
        y = y + conv_w[i] * u[:, i:i + S]
    return b * y


def stick_breaking_mixer(q, k, v, q_g, k_g):
    Bn, S, _ = q.shape
    def heads(t):
        return t.reshape(Bn, S, SB_HEADS, SB_HEAD_DIM).transpose(0, 2, 1, 3)
    qh = rms_norm(heads(q), q_g).astype(jnp.float32)
    kh = rms_norm(heads(k), k_g).astype(jnp.float32)
    vh = heads(v).astype(jnp.float32)
    scale = SB_HEAD_DIM ** -0.5
    outs = []
    for blk in range(S // SB_BLOCK):
        start = blk * SB_BLOCK
        end = start + SB_BLOCK
        kp = kh[:, :, :end]
        vp = vh[:, :, :end]
        z = jnp.einsum('bhtd,bhsd->bhts', qh[:, :, start:end], kp) * scale
        mask = jnp.arange(end)[None, :] < jnp.arange(start, end)[:, None]
        log_rem = jnp.where(mask, jax.nn.log_sigmoid(-z), 0.0)
        csum = jnp.cumsum(log_rem, axis=-1)
        log_a = jax.nn.log_sigmoid(z) + csum[..., -1:] - csum
        a = jnp.where(mask, jnp.exp(log_a), 0.0)
        outs.append(jnp.einsum('bhts,bhsd->bhtd', a, vp))
    o = jnp.concatenate(outs, axis=2)
    return o.transpose(0, 2, 1, 3).reshape(Bn, S, GROUP_WIDTH).astype(q.dtype)


def gla_mixer(q, k, v, r, a_lr, a_w, a_b, norm_g):
    Bn, S, _ = q.shape
    n_chunks = S // CHUNK
    log_f = jax.nn.log_sigmoid((a_lr @ a_w + a_b).astype(jnp.float32)) / GLA_TAU
    def chunks(t, d):
        t = t.astype(jnp.float32).reshape(Bn, n_chunks, CHUNK, GLA_HEADS, d)
        return t.transpose(1, 0, 3, 2, 4)
    qc = chunks(q * GLA_DK ** -0.5, GLA_DK)
    kc = chunks(k, GLA_DK)
    vc = chunks(v, GLA_DV)
    gc = chunks(log_f, GLA_DK)
    causal = jnp.tril(jnp.ones((CHUNK, CHUNK), dtype=bool))[..., None]

    def step(state, inp):
        qi, ki, vi, gi = inp
        b = jnp.cumsum(gi, axis=-2)
        o_inter = jnp.einsum('bhtk,bhkv->bhtv', qi * jnp.exp(b), state)
        diff = b[:, :, :, None, :] - b[:, :, None, :, :]
        decay = jnp.where(causal, jnp.exp(jnp.where(causal, diff, 0.0)), 0.0)
        att = jnp.einsum('bhtk,bhsk,bhtsk->bhts', qi, ki, decay)
        o = o_inter + jnp.einsum('bhts,bhsv->bhtv', att, vi)
        b_last = b[:, :, -1:, :]
        state = (jnp.exp(b_last[:, :, 0, :, None]) * state
                 + jnp.einsum('bhsk,bhsv->bhkv', ki * jnp.exp(b_last - b), vi))
        return state, o

    s0 = jnp.zeros((Bn, GLA_HEADS, GLA_DK, GLA_DV), jnp.float32)
    _, o = lax.scan(step, s0, (qc, kc, vc, gc))
    o = o.transpose(1, 0, 3, 2, 4).reshape(Bn, S, GLA_HEADS, GLA_DV)
    o = rms_norm(o, norm_g).reshape(Bn, S, GROUP_WIDTH)
    o = o * jax.nn.silu(r.astype(jnp.float32))
    return o.astype(q.dtype)


def pool_mixer(u, pool_w, pool_scale):
    Bn, S, _ = u.shape
    uf = u.astype(jnp.float32).reshape(Bn, S, len(POOL_WINDOWS), POOL_GROUP)
    cs = jnp.cumsum(uf, axis=1)
    outs = []
    for g, w in enumerate(POOL_WINDOWS):
        csg = cs[:, :, g]
        prev = jnp.pad(csg[:, :S - w], ((0, 0), (w, 0), (0, 0)))
        count = jnp.minimum(jnp.arange(1, S + 1), w).astype(jnp.float32)[None, :, None]
        outs.append((csg - prev) / count - uf[:, :, g])
    pooled = jnp.stack(outs, axis=2)
    y = jnp.einsum('bsgc,gcd->bsgd', pooled, pool_w.astype(jnp.float32)).reshape(Bn, S, GROUP_WIDTH)
    return (y * pool_scale.astype(jnp.float32)).astype(u.dtype)


def setup_inputs(seed: int = 0) -> dict:
    key = jax.random.key(seed)
    ks = jax.random.split(key, 16)
    f32 = jnp.float32
    def nrm(k, shape, scale):
        return jax.random.normal(k, shape, f32) * scale
    return {
        'x': jax.random.normal(ks[0], (BATCH, SEQ, D_MODEL), f32),
        'norm1_g': 1.0 + nrm(ks[1], (DEPTH, D_MODEL), 0.02),
        'w_in': nrm(ks[2], (DEPTH, D_MODEL, IN_COLS), D_MODEL ** -0.5),
        'conv_w': nrm(ks[3], (DEPTH, CONV_K, GROUP_WIDTH), CONV_K ** -0.5),
        'sb_q_g': 1.0 + nrm(ks[4], (DEPTH, SB_HEAD_DIM), 0.02),
        'sb_k_g': 1.0 + nrm(ks[5], (DEPTH, SB_HEAD_DIM), 0.02),
        'gla_a_w': nrm(ks[6], (DEPTH, GLA_GATE_RANK, GLA_HEADS * GLA_DK), GLA_GATE_RANK ** -0.5),
        'gla_a_b': nrm(ks[7], (DEPTH, GLA_HEADS * GLA_DK), 0.1),
        'gla_norm_g': 1.0 + nrm(ks[8], (DEPTH, GLA_DV), 0.02),
        'pool_w': nrm(ks[9], (DEPTH, len(POOL_WINDOWS), POOL_GROUP, POOL_GROUP), POOL_GROUP ** -0.5),
        'pool_scale': 1.0 + nrm(ks[10], (DEPTH, GROUP_WIDTH), 0.02),
        'w_out': nrm(ks[11], (DEPTH, MIX_WIDTH, D_MODEL), MIX_WIDTH ** -0.5),
        'norm2_g': 1.0 + nrm(ks[12], (DEPTH, D_MODEL), 0.02),
        'w_gate': nrm(ks[13], (DEPTH, D_MODEL, D_FF), D_MODEL ** -0.5),
        'w_up': nrm(ks[14], (DEPTH, D_MODEL, D_FF), D_MODEL ** -0.5),
        'w_down': nrm(ks[15], (DEPTH, D_FF, D_MODEL), D_FF ** -0.5),
    }


def reference(x, norm1_g, w_in, conv_w, sb_q_g, sb_k_g, gla_a_w, gla_a_b, gla_norm_g,
              pool_w, pool_scale, w_out, norm2_g, w_gate, w_up, w_down):
    for l in range(DEPTH):
        h = rms_norm(x, norm1_g[l])
        proj = h @ w_in[l]
        (c_b, c_c, c_h, s_q, s_k, s_v,
         g_q, g_k, g_v, g_r, g_a, p_u) = jnp.split(proj, IN_SPLIT_POINTS, axis=-1)
        y_conv = short_conv_mixer(c_b, c_c, c_h, conv_w[l])
        y_sb = stick_breaking_mixer(s_q, s_k, s_v, sb_q_g[l], sb_k_g[l])
        y_gla = gla_mixer(g_q, g_k, g_v, g_r, g_a, gla_a_w[l], gla_a_b[l], gla_norm_g[l])
        y_pool = pool_mixer(p_u, pool_w[l], pool_scale[l])
        mixed = jnp.concatenate([y_conv, y_sb, y_gla, y_pool], axis=-1)
        x = x + mixed @ w_out[l]
        h = rms_norm(x, norm2_g[l])
        x = x + (jax.nn.silu(h @ w_gate[l]) * (h @ w_up[l])) @ w_down[l]
    return x
```

```cpp
#include <hip/hip_runtime.h>
#include <cstdio>
#include <cstdint>

#define LAS __attribute__((address_space(3)))
typedef unsigned short bf16;
typedef float f32x4 __attribute__((ext_vector_type(4)));
typedef float f32x2 __attribute__((ext_vector_type(2)));
typedef unsigned u32x4 __attribute__((ext_vector_type(4)));
typedef unsigned u32x2 __attribute__((ext_vector_type(2)));
typedef short bf16x8 __attribute__((ext_vector_type(8)));

constexpr int D_MODEL = 2048, BATCH = 8, SEQ = 2048, DEPTH = 4, MTOK = BATCH * SEQ;
constexpr int GW = 512, IN_COLS = 5136, NPROJ = 5120, DFF = 5632, NGU = 2 * DFF;
constexpr float RMS_EPS = 1e-6f;
constexpr int PC_CB = 0, PC_CC = 512, PC_CH = 1024, PC_SQ = 1536, PC_SK = 2048, PC_SV = 2560, PC_GQ = 3072, PC_GK = 3328, PC_GV = 3584, PC_GR = 4096, PC_PU = 4608;
constexpr int MC_CONV = 0, MC_SB = 512, MC_GLA = 1024, MC_POOL = 1536;

constexpr size_t MiB = 1u << 20;
constexpr size_t WS_CTL = 0, CTL_BYTES = 1 * MiB;
constexpr size_t WS_WT = 1 * MiB;
constexpr size_t WT_IN = 0, WT_OUT = 21 * MiB, WT_GU = 29 * MiB, WT_DN = 73 * MiB, WT_PW = 95 * MiB, WT_STRIDE = 96 * MiB;
static_assert((size_t)(NPROJ + 16) * D_MODEL * 2 <= WT_OUT && (size_t)NGU * D_MODEL * 2 == 44 * MiB && (size_t)D_MODEL * DFF * 2 == 22 * MiB, "weight map");
constexpr size_t WS_H = WS_WT + DEPTH * WT_STRIDE;
constexpr size_t WS_PROJ = WS_H + 64 * MiB;
constexpr size_t WS_MIXED = WS_PROJ + 176 * MiB;
constexpr size_t WS_GA = WS_MIXED + 64 * MiB;
constexpr size_t WS_SCR = WS_GA + 1 * MiB;
constexpr size_t WS_END = WS_SCR + 96 * MiB;

struct Params {
    const float* x; const float* norm1_g; const float* w_in; const float* conv_w; const float* sb_q_g; const float* sb_k_g;
    const float* gla_a_w; const float* gla_a_b; const float* gla_norm_g; const float* pool_w; const float* pool_scale;
    const float* w_out; const float* norm2_g; const float* w_gate; const float* w_up; const float* w_down;
    float* out; unsigned char* ws;
};

#define LDS_WAIT() asm volatile("s_waitcnt lgkmcnt(0)" ::: "memory")
#define VM_WAIT() asm volatile("s_waitcnt vmcnt(0)" ::: "memory")
__device__ __forceinline__ float bf2f(unsigned b) { return __uint_as_float(b << 16); }
__device__ __forceinline__ float bflo(unsigned w) { return __uint_as_float(w << 16); }
__device__ __forceinline__ float bfhi(unsigned w) { return __uint_as_float(w & 0xffff0000u); }
__device__ __forceinline__ unsigned f2bf(float f) { unsigned u = __float_as_uint(f); return (u + 0x7fffu + ((u >> 16) & 1u)) >> 16; }
__device__ __forceinline__ unsigned pk2(float lo, float hi) { return f2bf(lo) | (f2bf(hi) << 16); }
__device__ __forceinline__ float wave_sum(float v) {
#pragma unroll
    for (int o = 1; o < 64; o <<= 1) v += __shfl_xor(v, o);
    return v;
}
__device__ __forceinline__ float log_sigmoid(float z) { return fminf(z, 0.f) - log1pf(expf(-fabsf(z))); }

struct Ctx { LAS unsigned char* lds; int tid, lane, wave, bid, G; };
namespace pg8 {
#define PG8_LAS __attribute__((address_space(3)))
typedef unsigned short bf16_t;
typedef short bf16x8 __attribute__((ext_vector_type(8)));
typedef float f32x4 __attribute__((ext_vector_type(4)));
typedef unsigned u32x4 __attribute__((ext_vector_type(4)));
constexpr int BM = 256, BK = 64, HALF = 128, HTB = HALF * BK * 2  , STAGE_BYTES = 8 * HTB, NXCD = 8, WGM = 8;

__host__ __device__ __forceinline__ int lds_byte(int r, int c) { const int st = (r >> 4) * 2 + (c >> 5), rr = r & 15, cc = c & 31, ob = rr * 64 + cc * 2; return st * 1024 + (ob ^ (((ob >> 9) & 1) << 5)); }
__host__ __device__ __forceinline__ void stage_rc(int b, int& R, int& C) { const int st = b / 1024, sb = b % 1024, swz = sb ^ (((sb >> 9) & 1) << 5); R = (st >> 1) * 16 + swz / 64; C = (st & 1) * 32 + (swz % 64) / 2; }
__host__ __device__ __forceinline__ int perm32(int rho) { const int n = rho >> 4, i = rho & 15; return 8 * (i >> 2) + 4 * n + (i & 3); }

struct Unit { int pm, pn; };
struct Gemm { const bf16_t* A; const bf16_t* Bt; int M, N, K; };

struct StaticOrder {
    int nM, nN, nwg, G, c;
    __host__ __device__ void init(int M, int N, int G_, int c_) { nM = M / BM; nN = N / BM; nwg = nM * nN; G = G_; c = c_; }
    __host__ __device__ bool next(int i, Unit& u) const {
        const long L = (long)i * G + c; if (L >= nwg) return false;
        int wgid = (int)L; { const int q = nwg / NXCD, r = nwg % NXCD, xcd = wgid % NXCD, off = wgid / NXCD; wgid = (xcd < r ? xcd * (q + 1) : r * (q + 1) + (xcd - r) * q) + off; }
        const int nig = WGM * nN, gid = wgid / nig, fm = gid * WGM, gsz = (nM - fm) < WGM ? (nM - fm) : WGM;
        u.pm = fm + ((wgid % nig) % gsz); u.pn = (wgid % nig) / gsz; return true;
    }
    __device__ __forceinline__ void a_ready(const Unit&) const {}
    __device__ __forceinline__ void done(const Unit&) const {}
};

__device__ __forceinline__ unsigned cvt_pk_bf16(float lo, float hi) { unsigned r; asm volatile("v_cvt_pk_bf16_f32 %0, %1, %2" : "=v"(r) : "v"(lo), "v"(hi)); return r; }

struct EpiStoreBf16 {
    static constexpr bool PERM = true, AFTER_DRAIN = false;
    bf16_t* O; int ldc;
    __device__ __forceinline__ void operator()(const f32x4 (&acc)[2][2][4][2], const Unit& u, int wr, int wc, int fr, int fq) const {
        const int row0 = u.pm * BM + wr * 64 + fr, col0 = u.pn * BM + wc * 32 + 8 * fq;
#pragma unroll
        for (int ai = 0; ai < 2; ++ai)
#pragma unroll
            for (int m = 0; m < 4; ++m) { bf16_t* rowp = O + (size_t)(row0 + ai * HALF + m * 16) * ldc + col0;
#pragma unroll
                for (int bj = 0; bj < 2; ++bj) { const f32x4 v0 = acc[ai][bj][m][0], v1 = acc[ai][bj][m][1];
                    u32x4 w; w.x = cvt_pk_bf16(v0[0], v0[1]); w.y = cvt_pk_bf16(v0[2], v0[3]); w.z = cvt_pk_bf16(v1[0], v1[1]); w.w = cvt_pk_bf16(v1[2], v1[3]);
                    *(u32x4*)(rowp + bj * HALF) = w; } }
    }
};
struct EpiResidF32 {
    static constexpr bool PERM = false, AFTER_DRAIN = false;
    const float* base; float* out; int ldc;
    __device__ __forceinline__ void operator()(const f32x4 (&acc)[2][2][4][2], const Unit& u, int wr, int wc, int fr, int fq) const {
        const int row0 = u.pm * BM + wr * 64 + fr, col0 = u.pn * BM + wc * 32 + 4 * fq;
#pragma unroll
        for (int ai = 0; ai < 2; ++ai)
#pragma unroll
            for (int m = 0; m < 4; ++m) { const size_t off = (size_t)(row0 + ai * HALF + m * 16) * ldc + col0;
#pragma unroll
                for (int bj = 0; bj < 2; ++bj)
#pragma unroll
                    for (int n = 0; n < 2; ++n) { const f32x4 bs = *(const f32x4*)(base + off + bj * HALF + n * 16); *(f32x4*)(out + off + bj * HALF + n * 16) = bs + acc[ai][bj][m][n]; }
                asm volatile("" ::: "memory"); }
    }
};
__device__ __forceinline__ float silu_mul(float g, float u) { return g * u * __builtin_amdgcn_rcpf(1.0f + __builtin_amdgcn_exp2f(-1.4426950408889634f * g)); }
struct EpiSwiGLU {
    static constexpr bool PERM = true, AFTER_DRAIN = false;
    bf16_t* O; int ldc;
    __device__ __forceinline__ void operator()(const f32x4 (&acc)[2][2][4][2], const Unit& u, int wr, int wc, int fr, int fq) const {
        const int row0 = u.pm * BM + wr * 64 + fr, col0 = u.pn * HALF + wc * 32 + 8 * fq;
#pragma unroll
        for (int ai = 0; ai < 2; ++ai)
#pragma unroll
            for (int m = 0; m < 4; ++m) { bf16_t* rowp = O + (size_t)(row0 + ai * HALF + m * 16) * ldc + col0;
                const f32x4 g0 = acc[ai][0][m][0], g1 = acc[ai][0][m][1], u0 = acc[ai][1][m][0], u1 = acc[ai][1][m][1];
                u32x4 w; w.x = cvt_pk_bf16(silu_mul(g0[0], u0[0]), silu_mul(g0[1], u0[1])); w.y = cvt_pk_bf16(silu_mul(g0[2], u0[2]), silu_mul(g0[3], u0[3]));
                w.z = cvt_pk_bf16(silu_mul(g1[0], u1[0]), silu_mul(g1[1], u1[1])); w.w = cvt_pk_bf16(silu_mul(g1[2], u1[2]), silu_mul(g1[3], u1[3]));
                *(u32x4*)rowp = w; }
    }
};
template <class Epi, class Sched, bool ALIGN_EPI = false, bool SP2 = false>
__device__ __forceinline__ void gemm_phase(PG8_LAS unsigned char* lds, const Gemm g, const Sched& S, const Epi& E) {
    const int tid = threadIdx.x, wid = __builtin_amdgcn_readfirstlane(tid >> 6), lane = tid & 63, wr = wid >> 2, wc = wid & 3, fr = lane & 15, fq = lane >> 4;
    const int K = g.K, nt = K / BK;
    unsigned voffA[2], voffB[2];
#pragma unroll
    for (int i = 0; i < 2; ++i) { int R, C; stage_rc(tid * 16 + i * 8192, R, C); const int Rb = Epi::PERM ? ((R & ~31) + perm32(R & 31)) : R;
        voffA[i] = (unsigned)(R * K + C) * 2u; voffB[i] = (unsigned)(Rb * K + C) * 2u; }
    const size_t kstep = (size_t)(BK * 2);
    const size_t hstep = (size_t)HALF * K * 2;
    const size_t tstep = 2 * hstep;
    const unsigned ldsw = (unsigned)wid * 1024u;
    const int aoff = lds_byte(wr * 64 + fr, fq * 8), boff = lds_byte(wc * 32 + fr, fq * 8);
#define PG8_SA(b, h) (((b) * 2 + (h)) * HTB)
#define PG8_SB(b, h) ((4 + (b) * 2 + (h)) * HTB)
#define PG8_STAGE(bufoff, gbase, voff) do { _Pragma("unroll") for (int _i = 0; _i < 2; ++_i) \
        __builtin_amdgcn_global_load_lds((const unsigned*)((const char*)(gbase) + (voff)[_i]), (PG8_LAS unsigned*)(lds + (bufoff) + ldsw + _i * 8192), 16, 0, 0); } while (0)
#define PG8_LDA(dst, b, h) do { _Pragma("unroll") for (int m = 0; m < 4; ++m) _Pragma("unroll") for (int k = 0; k < 2; ++k) dst[m][k] = *(const PG8_LAS bf16x8*)(lds + PG8_SA(b, h) + aoff + m * 2048 + k * 1024); } while (0)
#define PG8_LDB(dst, b, h) do { _Pragma("unroll") for (int n = 0; n < 2; ++n) _Pragma("unroll") for (int k = 0; k < 2; ++k) dst[n][k] = *(const PG8_LAS bf16x8*)(lds + PG8_SB(b, h) + boff + n * 2048 + k * 1024); } while (0)
#define PG8_MMA(ai, bj, At, Bt) do { __builtin_amdgcn_s_setprio(1); _Pragma("unroll") for (int m = 0; m < 4; ++m) _Pragma("unroll") for (int n = 0; n < 2; ++n) _Pragma("unroll") for (int k = 0; k < 2; ++k) \
        acc[ai][bj][m][n] = __builtin_amdgcn_mfma_f32_16x16x32_bf16(Bt[n][k], At[m][k], acc[ai][bj][m][n], 0, 0, 0); __builtin_amdgcn_s_setprio(0); } while (0)
#define PG8_WAIT_V(n) asm volatile("s_waitcnt vmcnt(" #n ")" ::: "memory")
#define PG8_WAIT_L(n) asm volatile("s_waitcnt lgkmcnt(" #n ")" ::: "memory")
#define PG8_BAR __builtin_amdgcn_s_barrier()
#define PG8_SCHED __builtin_amdgcn_sched_barrier(0)
    Unit cur, nxt; int ui = 0;
    if (!S.next(0, cur)) return;
    f32x4 acc[2][2][4][2];
#pragma unroll
    for (int a = 0; a < 2; ++a)
#pragma unroll
        for (int b = 0; b < 2; ++b)
#pragma unroll
            for (int m = 0; m < 4; ++m)
#pragma unroll
                for (int n = 0; n < 2; ++n) acc[a][b][m][n] = (f32x4){0.f, 0.f, 0.f, 0.f};
    bf16x8 At[4][2], B0[2][2], B1[2][2];
    const char* cA = (const char*)g.A + (size_t)cur.pm * tstep; const char* cB = (const char*)g.Bt + (size_t)cur.pn * tstep;
    S.a_ready(cur);
    if constexpr (SP2) {
        PG8_STAGE(PG8_SB(0, 0), cB, voffB); PG8_STAGE(PG8_SB(0, 1), cB + hstep, voffB); PG8_STAGE(PG8_SA(0, 0), cA, voffA); PG8_STAGE(PG8_SA(0, 1), cA + hstep, voffA);
        if (wr == 1) PG8_BAR;
        PG8_WAIT_V(2); PG8_BAR;
        PG8_STAGE(PG8_SB(1, 0), cB + kstep, voffB); PG8_STAGE(PG8_SA(1, 0), cA + kstep, voffA); PG8_STAGE(PG8_SB(1, 1), cB + hstep + kstep, voffB);
        PG8_WAIT_V(6); PG8_BAR;
    } else {
        PG8_STAGE(PG8_SB(0, 0), cB, voffB); PG8_STAGE(PG8_SA(0, 0), cA, voffA); PG8_STAGE(PG8_SB(0, 1), cB + hstep, voffB); PG8_STAGE(PG8_SA(0, 1), cA + hstep, voffA);
        if (wr == 1) PG8_BAR;
        PG8_WAIT_V(4); PG8_BAR;
        PG8_STAGE(PG8_SB(1, 0), cB + kstep, voffB); PG8_STAGE(PG8_SA(1, 0), cA + kstep, voffA); PG8_STAGE(PG8_SB(1, 1), cB + hstep + kstep, voffB);
        PG8_WAIT_V(6); PG8_BAR;
    }
    for (;;) {
        const bool has_next = S.next(ui + 1, nxt);
        const char* nA = has_next ? (const char*)g.A + (size_t)nxt.pm * tstep : cA; const char* nB = has_next ? (const char*)g.Bt + (size_t)nxt.pn * tstep : cB;
        for (int t = 0; t < nt; t += 2) {
            const bool last = (t == nt - 2);
            const char* a1 = cA + (size_t)(t + 1) * kstep;
            const char* a2 = last ? nA : cA + (size_t)(t + 2) * kstep; const char* b2 = last ? nB : cB + (size_t)(t + 2) * kstep;
            const char* a3 = a2 + kstep; const char* b3 = b2 + kstep;
            if (last && has_next) S.a_ready(nxt);
            if constexpr (SP2) {
            PG8_LDB(B0, 0, 0); PG8_LDB(B1, 0, 1); PG8_SCHED; PG8_LDA(At, 0, 0); PG8_STAGE(PG8_SA(1, 1), a1 + hstep, voffA);
            PG8_WAIT_V(8); PG8_WAIT_L(0); PG8_BAR; PG8_MMA(0, 0, At, B0); PG8_MMA(0, 1, At, B1); PG8_BAR; PG8_SCHED;
            PG8_LDA(At, 0, 1); PG8_STAGE(PG8_SB(0, 0), b2, voffB); PG8_STAGE(PG8_SB(0, 1), b2 + hstep, voffB); PG8_STAGE(PG8_SA(0, 0), a2, voffA);
            PG8_WAIT_V(8); PG8_WAIT_L(0); PG8_BAR; PG8_MMA(1, 0, At, B0); PG8_MMA(1, 1, At, B1); PG8_BAR; PG8_SCHED;
            PG8_LDB(B0, 1, 0); PG8_LDB(B1, 1, 1); PG8_SCHED; PG8_LDA(At, 1, 0); PG8_STAGE(PG8_SA(0, 1), a2 + hstep, voffA);
            PG8_WAIT_V(8); PG8_WAIT_L(0); PG8_BAR; PG8_MMA(0, 0, At, B0); PG8_MMA(0, 1, At, B1); PG8_BAR; PG8_SCHED;
            PG8_LDA(At, 1, 1); PG8_STAGE(PG8_SB(1, 0), b3, voffB); PG8_STAGE(PG8_SB(1, 1), b3 + hstep, voffB); PG8_STAGE(PG8_SA(1, 0), a3, voffA);
            PG8_WAIT_V(8); PG8_WAIT_L(0); PG8_BAR; PG8_MMA(1, 0, At, B0); PG8_MMA(1, 1, At, B1); PG8_BAR; PG8_SCHED;
            } else {
            PG8_LDB(B0, 0, 0); PG8_SCHED; PG8_LDA(At, 0, 0); PG8_STAGE(PG8_SA(1, 1), a1 + hstep, voffA);
            PG8_WAIT_L(8); PG8_BAR; PG8_WAIT_L(0); PG8_MMA(0, 0, At, B0); PG8_BAR; PG8_SCHED;
            PG8_LDB(B1, 0, 1); PG8_STAGE(PG8_SB(0, 0), b2, voffB);
            PG8_BAR; PG8_WAIT_L(0); PG8_MMA(0, 1, At, B1); PG8_BAR;
            PG8_LDA(At, 0, 1); PG8_STAGE(PG8_SA(0, 0), a2, voffA);
            PG8_BAR; PG8_WAIT_L(0); PG8_MMA(1, 0, At, B0); PG8_BAR; PG8_SCHED;
            PG8_STAGE(PG8_SB(0, 1), b2 + hstep, voffB);
            PG8_WAIT_V(6); PG8_BAR; PG8_MMA(1, 1, At, B1); PG8_BAR;
            PG8_LDB(B0, 1, 0); PG8_SCHED; PG8_LDA(At, 1, 0); PG8_STAGE(PG8_SA(0, 1), a2 + hstep, voffA);
            PG8_WAIT_L(8); PG8_BAR; PG8_WAIT_L(0); PG8_MMA(0, 0, At, B0); PG8_BAR; PG8_SCHED;
            PG8_LDB(B1, 1, 1); PG8_STAGE(PG8_SB(1, 0), b3, voffB);
            PG8_BAR; PG8_WAIT_L(0); PG8_MMA(0, 1, At, B1); PG8_BAR;
            PG8_LDA(At, 1, 1); PG8_STAGE(PG8_SA(1, 0), a3, voffA);
            PG8_BAR; PG8_WAIT_L(0); PG8_MMA(1, 0, At, B0); PG8_BAR; PG8_SCHED;
            PG8_STAGE(PG8_SB(1, 1), b3 + hstep, voffB);
            PG8_WAIT_V(6); PG8_BAR; PG8_MMA(1, 1, At, B1); PG8_BAR;
            }
        }
        if constexpr (ALIGN_EPI) { if (wr == 0) PG8_BAR; }
        if constexpr (!Epi::AFTER_DRAIN) { E(acc, cur, wr, wc, fr, fq); S.done(cur); }
        if (!has_next) break;
#pragma unroll
        for (int a = 0; a < 2; ++a)
#pragma unroll
            for (int b = 0; b < 2; ++b)
#pragma unroll
                for (int m = 0; m < 4; ++m)
#pragma unroll
                    for (int n = 0; n < 2; ++n) acc[a][b][m][n] = (f32x4){0.f, 0.f, 0.f, 0.f};
        cur = nxt; cA = nA; cB = nB; ++ui;
        if constexpr (ALIGN_EPI) { if (wr == 1) PG8_BAR; }
    }
    PG8_WAIT_V(0);
    if constexpr (!ALIGN_EPI) { if (wr == 0) PG8_BAR; }
    PG8_BAR;
    if constexpr (Epi::AFTER_DRAIN) { E.fused(acc, cur, wr, wc, fr, fq, lds, wid, lane); S.done(cur); }
#undef PG8_SA
#undef PG8_SB
#undef PG8_STAGE
#undef PG8_LDA
#undef PG8_LDB
#undef PG8_MMA
#undef PG8_WAIT_V
#undef PG8_WAIT_L
#undef PG8_BAR
#undef PG8_SCHED
}
}
__device__ __forceinline__ bf16* ws_wt(const Params& P, int l, size_t off) { return (bf16*)(P.ws + WS_WT + (size_t)l * WT_STRIDE + off); }
__device__ __forceinline__ bf16* ws_h(const Params& P) { return (bf16*)(P.ws + WS_H); }
__device__ __forceinline__ bf16* ws_proj(const Params& P) { return (bf16*)(P.ws + WS_PROJ); }
__device__ __forceinline__ bf16* ws_ff(const Params& P) { return (bf16*)(P.ws + WS_PROJ); }
__device__ __forceinline__ bf16* ws_mixed(const Params& P) { return (bf16*)(P.ws + WS_MIXED); }
__device__ __forceinline__ float* ws_ga(const Params& P) { return (float*)(P.ws + WS_GA); }

__device__ __forceinline__ void transpose_item(const float* W, int ldw, int col0, int ncols, bf16* WT, int ldt, int drow0, int k0, LAS float* scr, int lane) {
#pragma unroll 8
    for (int i = 0; i < 32; ++i) { const int kk = 2 * i + (lane >> 5), c = lane & 31; scr[kk * 33 + c] = (c < ncols) ? W[(size_t)(k0 + kk) * ldw + col0 + c] : 0.f; }
    LDS_WAIT();
    const int c8 = lane & 7;
#pragma unroll
    for (int j = 0; j < 4; ++j) { const int n = (lane >> 3) + 8 * j; const LAS float* s = scr + (8 * c8) * 33 + n;
        u32x4 o; o.x = pk2(s[0 * 33], s[1 * 33]); o.y = pk2(s[2 * 33], s[3 * 33]); o.z = pk2(s[4 * 33], s[5 * 33]); o.w = pk2(s[6 * 33], s[7 * 33]);
        if (n < ncols) *(u32x4*)(WT + (size_t)(drow0 + n) * ldt + k0 + 8 * c8) = o; }
    LDS_WAIT();
}
constexpr int CV_IN = 161 * 32, CV_OUT = 64 * 32, CV_GU = 176 * 32, CV_DN = 64 * 88, CV_PW = 32, CV_LAYER = CV_IN + CV_OUT + 3 * CV_GU + CV_PW;
static_assert(CV_GU == CV_DN, "gate/up/down item counts");
__device__ __forceinline__ void ph_convert(const Params& P, const Ctx& C) {
    LAS float* scr = (LAS float*)(C.lds + C.wave * 8704);
    const int gw = C.bid * 8 + C.wave, NGW = C.G * 8;
    for (int it = gw; it < DEPTH * CV_LAYER; it += NGW) {
        const int l = it / CV_LAYER; int r = it % CV_LAYER;
        if (r < CV_IN) { const int nb = r % 161, kb = r / 161; int col0, drow0, nc = 32;
            if (nb < 144) { col0 = 32 * nb; drow0 = 32 * nb; } else if (nb < 160) { col0 = 4624 + 32 * (nb - 144); drow0 = 4608 + 32 * (nb - 144); } else { col0 = 4608; drow0 = NPROJ; nc = 16; }
            transpose_item(P.w_in + (size_t)l * D_MODEL * IN_COLS, IN_COLS, col0, nc, ws_wt(P, l, WT_IN), D_MODEL, drow0, 64 * kb, scr, C.lane); continue; }
        r -= CV_IN;
        if (r < CV_OUT) { const int nb = r % 64, kb = r / 64;
            transpose_item(P.w_out + (size_t)l * D_MODEL * D_MODEL, D_MODEL, 32 * nb, 32, ws_wt(P, l, WT_OUT), D_MODEL, 32 * nb, 64 * kb, scr, C.lane); continue; }
        r -= CV_OUT;
        if (r < 2 * CV_GU) { const int up = r >= CV_GU; if (up) r -= CV_GU; const int nb = r % 176, kb = r / 176;
            transpose_item((up ? P.w_up : P.w_gate) + (size_t)l * D_MODEL * DFF, DFF, 32 * nb, 32, ws_wt(P, l, WT_GU), D_MODEL, 256 * (nb >> 2) + 32 * (nb & 3) + (up ? 128 : 0), 64 * kb, scr, C.lane); continue; }
        r -= 2 * CV_GU;
        if (r < CV_DN) { const int nb = r % 64, kb = r / 64;
            transpose_item(P.w_down + (size_t)l * DFF * D_MODEL, D_MODEL, 32 * nb, 32, ws_wt(P, l, WT_DN), DFF, 32 * nb, 64 * kb, scr, C.lane); continue; }
        r -= CV_DN;
        { const int g = r >> 3, nb = r & 3, kb = (r >> 2) & 1;
            transpose_item(P.pool_w + (size_t)(l * 4 + g) * 128 * 128, 128, 32 * nb, 32, ws_wt(P, l, WT_PW) + (size_t)g * 128 * 128, 128, 32 * nb, 64 * kb, scr, C.lane); }
    }
}

__device__ __forceinline__ void ph_rmsnorm(const float* x, const float* g, bf16* h, const Ctx& C) {
    const int gw = C.bid * 8 + C.wave, NGW = C.G * 8;
    for (int m = gw; m < MTOK; m += NGW) {
        const f32x4* xr = (const f32x4*)(x + (size_t)m * D_MODEL) + C.lane;
        f32x4 v[8]; float s = 0.f;
#pragma unroll
        for (int j = 0; j < 8; ++j) { v[j] = xr[64 * j]; s += (v[j].x * v[j].x + v[j].y * v[j].y) + (v[j].z * v[j].z + v[j].w * v[j].w); }
        const float rstd = 1.0f / sqrtf(wave_sum(s) * (1.0f / D_MODEL) + RMS_EPS);
        u32x2* o8 = (u32x2*)(h + (size_t)m * D_MODEL) + C.lane;
#pragma unroll
        for (int j = 0; j < 8; ++j) { const f32x4 gg = ((const f32x4*)g)[C.lane + 64 * j];
            u32x2 w; w.x = pk2(v[j].x * rstd * gg.x, v[j].y * rstd * gg.y); w.y = pk2(v[j].z * rstd * gg.z, v[j].w * rstd * gg.w); o8[64 * j] = w; }
    }
}

__device__ __forceinline__ float dot8_bf16(const u32x4 a, const u32x4 b) {
    return bflo(a.x) * bflo(b.x) + bfhi(a.x) * bfhi(b.x) + bflo(a.y) * bflo(b.y) + bfhi(a.y) * bfhi(b.y) + bflo(a.z) * bflo(b.z) + bfhi(a.z) * bfhi(b.z) + bflo(a.w) * bflo(b.w) + bfhi(a.w) * bfhi(b.w);
}
__device__ __forceinline__ void ph_ga_naive(const Params& P, int l, const Ctx& C) {
    const bf16* h = ws_h(P); const bf16* wa = ws_wt(P, l, WT_IN) + (size_t)NPROJ * D_MODEL; float* ga = ws_ga(P);
    const int gw = C.bid * 8 + C.wave, NGW = C.G * 8;
    for (int m = gw; m < MTOK; m += NGW) {
        float acc[16];
#pragma unroll
        for (int j = 0; j < 16; ++j) acc[j] = 0.f;
#pragma unroll 1
        for (int i = 0; i < 4; ++i) {
            const u32x4 hv = *(const u32x4*)(h + (size_t)m * D_MODEL + 8 * C.lane + 512 * i);
#pragma unroll
            for (int j = 0; j < 16; ++j) { const u32x4 wv = *(const u32x4*)(wa + (size_t)j * D_MODEL + 8 * C.lane + 512 * i); acc[j] += dot8_bf16(hv, wv); }
        }
        float val = 0.f;
#pragma unroll
        for (int j = 0; j < 16; ++j) { const float s = wave_sum(acc[j]); val = (C.lane == j) ? s : val; }
        if (C.lane < 16) ga[(size_t)m * 16 + C.lane] = val;
    }
}

__device__ __forceinline__ void ph_conv(const Params& P, int l, const Ctx& C) {
    const bf16* proj = ws_proj(P); bf16* mixed = ws_mixed(P); const float* cw = P.conv_w + (size_t)l * 3 * GW;
    for (int it = C.bid * 512 + C.tid; it < MTOK * 64; it += C.G * 512) {
        const int m = it >> 6, c8 = (it & 63) * 8, t = m & (SEQ - 1);
        float acc[8];
#pragma unroll
        for (int e = 0; e < 8; ++e) acc[e] = 0.f;
#pragma unroll
        for (int i = 0; i < 3; ++i) { if (t - 2 + i >= 0) {
            const u32x4 cc = *(const u32x4*)(proj + (size_t)(m - 2 + i) * NPROJ + PC_CC + c8), hh = *(const u32x4*)(proj + (size_t)(m - 2 + i) * NPROJ + PC_CH + c8);
            const f32x4 w0 = *(const f32x4*)(cw + i * GW + c8), w1 = *(const f32x4*)(cw + i * GW + c8 + 4);
            acc[0] += w0.x * bflo(cc.x) * bflo(hh.x); acc[1] += w0.y * bfhi(cc.x) * bfhi(hh.x); acc[2] += w0.z * bflo(cc.y) * bflo(hh.y); acc[3] += w0.w * bfhi(cc.y) * bfhi(hh.y);
            acc[4] += w1.x * bflo(cc.z) * bflo(hh.z); acc[5] += w1.y * bfhi(cc.z) * bfhi(hh.z); acc[6] += w1.z * bflo(cc.w) * bflo(hh.w); acc[7] += w1.w * bfhi(cc.w) * bfhi(hh.w); } }
        const u32x4 bb = *(const u32x4*)(proj + (size_t)m * NPROJ + PC_CB + c8);
        u32x4 o; o.x = pk2(bflo(bb.x) * acc[0], bfhi(bb.x) * acc[1]); o.y = pk2(bflo(bb.y) * acc[2], bfhi(bb.y) * acc[3]); o.z = pk2(bflo(bb.z) * acc[4], bfhi(bb.z) * acc[5]); o.w = pk2(bflo(bb.w) * acc[6], bfhi(bb.w) * acc[7]);
        *(u32x4*)(mixed + (size_t)m * D_MODEL + MC_CONV + c8) = o;
    }
}

__device__ __forceinline__ void ph_pool_naive(const Params& P, int l, const Ctx& C) {
    const bf16* proj = ws_proj(P); bf16* mixed = ws_mixed(P);
    LAS float* Ps = (LAS float*)C.lds;
    for (int unit = C.bid; unit < 256 * 4; unit += C.G) {
        const int g = unit & 3, m0 = (unit >> 2) * 64, w = 2 << g;
        __syncthreads();
        { const int c = C.tid & 127, tq = C.tid >> 7;
          for (int tk = 0; tk < 16; ++tk) { const int m = m0 + 16 * tq + tk, t = m & (SEQ - 1), cnt = (t + 1 < w) ? t + 1 : w; float s = 0.f;
              for (int i = 0; i < cnt; ++i) s += bf2f(proj[(size_t)(m - i) * NPROJ + PC_PU + g * 128 + c]);
              Ps[(16 * tq + tk) * 128 + c] = s / (float)cnt - bf2f(proj[(size_t)m * NPROJ + PC_PU + g * 128 + c]); } }
        __syncthreads();
        { const int d = C.tid & 127, tq = C.tid >> 7; const float* pw = P.pool_w + (size_t)(l * 4 + g) * 128 * 128; float acc[16];
#pragma unroll
          for (int tk = 0; tk < 16; ++tk) acc[tk] = 0.f;
          for (int c = 0; c < 128; ++c) { const float wv = pw[c * 128 + d];
#pragma unroll
              for (int tk = 0; tk < 16; ++tk) acc[tk] += Ps[(16 * tq + tk) * 128 + c] * wv; }
          const float sc = P.pool_scale[l * GW + g * 128 + d];
#pragma unroll
          for (int tk = 0; tk < 16; ++tk) mixed[(size_t)(m0 + 16 * tq + tk) * D_MODEL + MC_POOL + g * 128 + d] = (bf16)f2bf(acc[tk] * sc); }
    }
}

__device__ __forceinline__ void ph_sb_naive(const Params& P, int l, const Ctx& C) {
    const bf16* proj = ws_proj(P); bf16* mixed = ws_mixed(P);
    LAS float* Ks = (LAS float*)C.lds;
    LAS float* Vs = Ks + 64 * 129;
    LAS float* Qs = Vs + 64 * 128;
    const float* qg = P.sb_q_g + l * 128; const float* kg = P.sb_k_g + l * 128;
    const int w = C.wave, lane = C.lane;
    for (int unit = C.bid; unit < 32 * 256; unit += C.G) {
        const int bh = unit >> 8, tg = unit & 255, b = bh >> 2, h = bh & 3, t0 = 8 * tg; const size_t mrow0 = (size_t)b * SEQ;
        __syncthreads();
        { const unsigned q2 = *(const unsigned*)(proj + (mrow0 + t0 + w) * NPROJ + PC_SQ + h * 128 + 2 * lane); const float qa = bflo(q2), qb = bfhi(q2);
          const float r = 1.0f / sqrtf(wave_sum(qa * qa + qb * qb) * (1.0f / 128.f) + RMS_EPS) * 0.08838834764831845f;
          Qs[w * 128 + 2 * lane] = qa * r * qg[2 * lane]; Qs[w * 128 + 2 * lane + 1] = qb * r * qg[2 * lane + 1]; }
        const int t = t0 + w; float carry = 0.f, o0 = 0.f, o1 = 0.f;
        const int nkb = (t0 + 6) / 64 + 1;
        for (int kb = nkb - 1; kb >= 0; --kb) {
            __syncthreads();
            for (int rr = 0; rr < 8; ++rr) { const int r = 8 * w + rr; const size_t mrow = mrow0 + kb * 64 + r;
                const unsigned k2 = *(const unsigned*)(proj + mrow * NPROJ + PC_SK + h * 128 + 2 * lane), v2 = *(const unsigned*)(proj + mrow * NPROJ + PC_SV + h * 128 + 2 * lane);
                const float ka = bflo(k2), kb2 = bfhi(k2); const float rs = 1.0f / sqrtf(wave_sum(ka * ka + kb2 * kb2) * (1.0f / 128.f) + RMS_EPS);
                Ks[r * 129 + 2 * lane] = ka * rs * kg[2 * lane]; Ks[r * 129 + 2 * lane + 1] = kb2 * rs * kg[2 * lane + 1];
                Vs[r * 128 + 2 * lane] = bflo(v2); Vs[r * 128 + 2 * lane + 1] = bfhi(v2); }
            __syncthreads();
            const int s = kb * 64 + lane; const bool valid = s < t;
            float z = 0.f;
#pragma unroll 8
            for (int d = 0; d < 128; ++d) z += Qs[w * 128 + d] * Ks[lane * 129 + d];
            const float ls = log_sigmoid(z), lr = valid ? ls - z : 0.f;
            float incl = lr;
#pragma unroll
            for (int o = 1; o < 64; o <<= 1) { const float tmp = __shfl_down(incl, o); if (lane + o < 64) incl += tmp; }
            const float sfx = incl - lr, total = __shfl(incl, 0);
            const float a = valid ? expf(ls + sfx + carry) : 0.f;
            carry += total;
#pragma unroll 8
            for (int j = 0; j < 64; ++j) { const float aj = __shfl(a, j); o0 += aj * Vs[j * 128 + lane]; o1 += aj * Vs[j * 128 + lane + 64]; }
        }
        bf16* orow = mixed + (mrow0 + t) * D_MODEL + MC_SB + h * 128;
        orow[lane] = (bf16)f2bf(o0); orow[lane + 64] = (bf16)f2bf(o1);
    }
}

__device__ __forceinline__ void ph_gla_naive(const Params& P, int l, const Ctx& C) {
    const bf16* proj = ws_proj(P); bf16* mixed = ws_mixed(P); const float* ga = ws_ga(P);
    LAS float* Qs = (LAS float*)C.lds;
    LAS float* Ks = Qs + 4096;
    LAS float* Fs = Ks + 4096;
    LAS float* Vs = Fs + 4096;
    LAS float* Os = Vs + 8192;
    LAS float* Gs = Os + 8192;
    LAS float* AW = Gs + 1024;
    LAS float* AB = AW + 1024;
    const int tid = C.tid, lane = C.lane, w = C.wave, kq = lane >> 4, v16 = lane & 15;
    const float* ng = P.gla_norm_g + l * 128;
    for (int unit = C.bid; unit < 32; unit += C.G) {
        const int b = unit >> 2, h = unit & 3;
        __syncthreads();
        for (int i = tid; i < 1024; i += 512) AW[i] = P.gla_a_w[(size_t)l * 16 * 256 + (i >> 6) * 256 + h * 64 + (i & 63)];
        if (tid < 64) AB[tid] = P.gla_a_b[l * 256 + h * 64 + tid];
        float S[16];
#pragma unroll
        for (int i = 0; i < 16; ++i) S[i] = 0.f;
        for (int c = 0; c < 32; ++c) {
            const size_t m0 = (size_t)b * SEQ + 64 * c;
            __syncthreads();
            { const int row = tid >> 3, c8 = (tid & 7) * 8;
              const u32x4 q4 = *(const u32x4*)(proj + (m0 + row) * NPROJ + PC_GQ + h * 64 + c8), k4 = *(const u32x4*)(proj + (m0 + row) * NPROJ + PC_GK + h * 64 + c8);
              LAS float* qd = Qs + row * 64 + c8; LAS float* kd = Ks + row * 64 + c8;
              qd[0] = bflo(q4.x) * 0.125f; qd[1] = bfhi(q4.x) * 0.125f; qd[2] = bflo(q4.y) * 0.125f; qd[3] = bfhi(q4.y) * 0.125f; qd[4] = bflo(q4.z) * 0.125f; qd[5] = bfhi(q4.z) * 0.125f; qd[6] = bflo(q4.w) * 0.125f; qd[7] = bfhi(q4.w) * 0.125f;
              kd[0] = bflo(k4.x); kd[1] = bfhi(k4.x); kd[2] = bflo(k4.y); kd[3] = bfhi(k4.y); kd[4] = bflo(k4.z); kd[5] = bfhi(k4.z); kd[6] = bflo(k4.w); kd[7] = bfhi(k4.w);
              const int c16 = (tid & 7) * 16;
#pragma unroll
              for (int hh = 0; hh < 2; ++hh) { const u32x4 v4 = *(const u32x4*)(proj + (m0 + row) * NPROJ + PC_GV + h * 128 + c16 + 8 * hh); LAS float* vd = Vs + row * 128 + c16 + 8 * hh;
                  vd[0] = bflo(v4.x); vd[1] = bfhi(v4.x); vd[2] = bflo(v4.y); vd[3] = bfhi(v4.y); vd[4] = bflo(v4.z); vd[5] = bfhi(v4.z); vd[6] = bflo(v4.w); vd[7] = bfhi(v4.w); }
              if (tid < 256) { const f32x4 g4 = *(const f32x4*)(ga + (m0 + (tid >> 2)) * 16 + (tid & 3) * 4); LAS float* gd = Gs + (tid >> 2) * 16 + (tid & 3) * 4; gd[0] = g4.x; gd[1] = g4.y; gd[2] = g4.z; gd[3] = g4.w; } }
            __syncthreads();
            { const int row = tid >> 3, k8 = (tid & 7) * 8;
#pragma unroll
              for (int e = 0; e < 8; ++e) { const int k = k8 + e; float lg = AB[k];
#pragma unroll
                  for (int j = 0; j < 16; ++j) lg += Gs[row * 16 + j] * AW[j * 64 + k];
                  Fs[row * 64 + k] = expf(log_sigmoid(lg) * (1.0f / 16.0f)); } }
            __syncthreads();
            for (int t = 0; t < 64; ++t) {
                const float vv = Vs[t * 128 + 16 * w + v16]; float oo = 0.f;
#pragma unroll
                for (int i = 0; i < 16; ++i) { const int kk = 16 * kq + i; S[i] = Fs[t * 64 + kk] * S[i] + Ks[t * 64 + kk] * vv; oo += Qs[t * 64 + kk] * S[i]; }
                oo += __shfl_xor(oo, 16); oo += __shfl_xor(oo, 32);
                if (kq == 0) Os[t * 128 + 16 * w + v16] = oo;
            }
            __syncthreads();
            for (int rr = 0; rr < 8; ++rr) { const int r = 8 * w + rr; const float oa = Os[r * 128 + 2 * lane], ob = Os[r * 128 + 2 * lane + 1];
                const float rstd = 1.0f / sqrtf(wave_sum(oa * oa + ob * ob) * (1.0f / 128.f) + RMS_EPS);
                const unsigned r2 = *(const unsigned*)(proj + (m0 + r) * NPROJ + PC_GR + h * 128 + 2 * lane); const float ra = bflo(r2), rb = bfhi(r2);
                const float ya = oa * rstd * ng[2 * lane] * (ra / (1.0f + expf(-ra))), yb = ob * rstd * ng[2 * lane + 1] * (rb / (1.0f + expf(-rb)));
                *(unsigned*)(mixed + (m0 + r) * D_MODEL + MC_GLA + h * 128 + 2 * lane) = pk2(ya, yb); }
        }
    }
}
__device__ __forceinline__ void ph_gemm_in(const Params& P, int l, const Ctx& C) {
    pg8::Gemm g{ws_h(P), ws_wt(P, l, WT_IN), MTOK, NPROJ, D_MODEL}; pg8::StaticOrder S; S.init(MTOK, NPROJ, C.G, C.bid);
    pg8::EpiStoreBf16 E{ws_proj(P), NPROJ};
    pg8::gemm_phase<pg8::EpiStoreBf16, pg8::StaticOrder, true, true>(C.lds, g, S, E);
}
__device__ __forceinline__ void ph_gemm_out(const Params& P, int l, const Ctx& C) {
    pg8::Gemm g{ws_mixed(P), ws_wt(P, l, WT_OUT), MTOK, D_MODEL, D_MODEL}; pg8::StaticOrder S; S.init(MTOK, D_MODEL, C.G, C.bid);
    pg8::EpiResidF32 E{l == 0 ? P.x : P.out, P.out, D_MODEL};
    pg8::gemm_phase<pg8::EpiResidF32, pg8::StaticOrder, true, true>(C.lds, g, S, E);
}
__device__ __forceinline__ void ph_gemm_gu(const Params& P, int l, const Ctx& C) {
    pg8::Gemm g{ws_h(P), ws_wt(P, l, WT_GU), MTOK, NGU, D_MODEL}; pg8::StaticOrder S; S.init(MTOK, NGU, C.G, C.bid);
    pg8::EpiSwiGLU E{ws_ff(P), DFF};
    pg8::gemm_phase<pg8::EpiSwiGLU, pg8::StaticOrder, true, true>(C.lds, g, S, E);
}
__device__ __forceinline__ void ph_gemm_dn(const Params& P, int l, const Ctx& C) {
    pg8::Gemm g{ws_ff(P), ws_wt(P, l, WT_DN), MTOK, D_MODEL, DFF}; pg8::StaticOrder S; S.init(MTOK, D_MODEL, C.G, C.bid);
    pg8::EpiResidF32 E{P.out, P.out, D_MODEL};
    pg8::gemm_phase<pg8::EpiResidF32, pg8::StaticOrder, true, true>(C.lds, g, S, E);
}

constexpr int LDS_BYTES = 147456;
enum Phase { PH_CONVERT = 0, PH_NORM1, PH_GEMM_IN, PH_GA, PH_CONV, PH_POOL, PH_SB, PH_GLA, PH_GEMM_OUT, PH_NORM2, PH_GEMM_GU, PH_GEMM_DN };
template <int PH> __global__ void __launch_bounds__(512, 2) k_phase(Params P, int l) {
    extern __shared__ __attribute__((aligned(16))) unsigned char lds[];
    Ctx C; C.lds = (LAS unsigned char*)lds; C.tid = threadIdx.x; C.lane = C.tid & 63; C.wave = __builtin_amdgcn_readfirstlane(C.tid >> 6); C.bid = blockIdx.x; C.G = gridDim.x;
    if constexpr (PH == PH_CONVERT) ph_convert(P, C);
    if constexpr (PH == PH_NORM1) ph_rmsnorm(l == 0 ? P.x : P.out, P.norm1_g + l * D_MODEL, ws_h(P), C);
    if constexpr (PH == PH_GEMM_IN) ph_gemm_in(P, l, C);
    if constexpr (PH == PH_GA) ph_ga_naive(P, l, C);
    if constexpr (PH == PH_CONV) ph_conv(P, l, C);
    if constexpr (PH == PH_POOL) ph_pool_naive(P, l, C);
    if constexpr (PH == PH_SB) ph_sb_naive(P, l, C);
    if constexpr (PH == PH_GLA) ph_gla_naive(P, l, C);
    if constexpr (PH == PH_GEMM_OUT) ph_gemm_out(P, l, C);
    if constexpr (PH == PH_NORM2) ph_rmsnorm(P.out, P.norm2_g + l * D_MODEL, ws_h(P), C);
    if constexpr (PH == PH_GEMM_GU) ph_gemm_gu(P, l, C);
    if constexpr (PH == PH_GEMM_DN) ph_gemm_dn(P, l, C);
}
template <int PH> static void launch_phase(const Params& P, int l, int grid, hipStream_t stream) {
    static bool attr = false;
    if (!attr) { if (hipFuncSetAttribute((const void*)k_phase<PH>, hipFuncAttributeMaxDynamicSharedMemorySize, LDS_BYTES) != hipSuccess) fprintf(stderr, "kernel_launch: hipFuncSetAttribute failed for phase %d\n", PH); attr = true; }
    hipLaunchKernelGGL((k_phase<PH>), dim3(grid), dim3(512), LDS_BYTES, stream, P, l);
}

extern "C" void kernel_launch(void* const* d_in, const int* in_sizes, int n_in, void* d_out, int out_size, void* d_ws, size_t ws_size, hipStream_t stream) {
    if (n_in != 16 || in_sizes[0] != MTOK * D_MODEL || out_size != MTOK * D_MODEL || ws_size < WS_END) {
        fprintf(stderr, "kernel_launch: unexpected shapes / workspace: n_in %d in0 %d out %d ws %zu (need %zu); nothing launched\n", n_in, n_in > 0 ? in_sizes[0] : -1, out_size, ws_size, (size_t)WS_END); return; }
    Params P{};
    P.x = (const float*)d_in[0]; P.norm1_g = (const float*)d_in[1]; P.w_in = (const float*)d_in[2]; P.conv_w = (const float*)d_in[3]; P.sb_q_g = (const float*)d_in[4]; P.sb_k_g = (const float*)d_in[5];
    P.gla_a_w = (const float*)d_in[6]; P.gla_a_b = (const float*)d_in[7]; P.gla_norm_g = (const float*)d_in[8]; P.pool_w = (const float*)d_in[9]; P.pool_scale = (const float*)d_in[10];
    P.w_out = (const float*)d_in[11]; P.norm2_g = (const float*)d_in[12]; P.w_gate = (const float*)d_in[13]; P.w_up = (const float*)d_in[14]; P.w_down = (const float*)d_in[15];
    P.out = (float*)d_out; P.ws = (unsigned char*)d_ws;
    const int G = 256;
    launch_phase<PH_CONVERT>(P, 0, G, stream);
    for (int l = 0; l < DEPTH; ++l) {
        launch_phase<PH_NORM1>(P, l, G, stream);
        launch_phase<PH_GEMM_IN>(P, l, G, stream);
        launch_phase<PH_GA>(P, l, G, stream);
        launch_phase<PH_CONV>(P, l, G, stream);
        launch_phase<PH_POOL>(P, l, G, stream);
        launch_phase<PH_SB>(P, l, G, stream);
        launch_phase<PH_GLA>(P, l, G, stream);
        launch_phase<PH_GEMM_OUT>(P, l, G, stream);
        launch_phase<PH_NORM2>(P, l, G, stream);
        launch_phase<PH_GEMM_GU>(P, l, G, stream);
        launch_phase<PH_GEMM_DN>(P, l, G, stream);
    }
}
```

```cpp
#include <hip/hip_runtime.h>
#include <cstdio>
#include <cstdint>

#define LAS __attribute__((address_space(3)))
typedef unsigned short bf16;
typedef float f32x4 __attribute__((ext_vector_type(4)));
typedef float f32x2 __attribute__((ext_vector_type(2)));
typedef unsigned u32x4 __attribute__((ext_vector_type(4)));
typedef unsigned u32x2 __attribute__((ext_vector_type(2)));
typedef short bf16x8 __attribute__((ext_vector_type(8)));

constexpr int D_MODEL = 2048, BATCH = 8, SEQ = 2048, DEPTH = 4, MTOK = BATCH * SEQ;
constexpr int GW = 512, IN_COLS = 5136, NPROJ = 5120, DFF = 5632, NGU = 2 * DFF;
constexpr float RMS_EPS = 1e-6f;
constexpr int PC_CB = 0, PC_CC = 512, PC_CH = 1024, PC_SQ = 1536, PC_SK = 2048, PC_SV = 2560, PC_GQ = 3072, PC_GK = 3328, PC_GV = 3584, PC_GR = 4096, PC_PU = 4608;
constexpr int MC_CONV = 0, MC_SB = 512, MC_GLA = 1024, MC_POOL = 1536;

constexpr size_t MiB = 1u << 20;
constexpr size_t WS_CTL = 0, CTL_BYTES = 1 * MiB;
constexpr size_t WS_WT = 1 * MiB;
constexpr size_t WT_IN = 0, WT_OUT = 21 * MiB, WT_GU = 29 * MiB, WT_DN = 73 * MiB, WT_PW = 95 * MiB, WT_STRIDE = 96 * MiB;
static_assert((size_t)(NPROJ + 16) * D_MODEL * 2 <= WT_OUT && (size_t)NGU * D_MODEL * 2 == 44 * MiB && (size_t)D_MODEL * DFF * 2 == 22 * MiB, "weight map");
constexpr size_t WS_H = WS_WT + DEPTH * WT_STRIDE;
constexpr size_t WS_PROJ = WS_H + 64 * MiB;
constexpr size_t WS_MIXED = WS_PROJ + 176 * MiB;
constexpr size_t WS_GA = WS_MIXED + 64 * MiB;
constexpr size_t WS_SCR = WS_GA + 1 * MiB;
constexpr size_t WS_END = WS_SCR + 96 * MiB;

struct Params {
    const float* x; const float* norm1_g; const float* w_in; const float* conv_w; const float* sb_q_g; const float* sb_k_g;
    const float* gla_a_w; const float* gla_a_b; const float* gla_norm_g; const float* pool_w; const float* pool_scale;
    const float* w_out; const float* norm2_g; const float* w_gate; const float* w_up; const float* w_down;
    float* out; unsigned char* ws;
};

#define LDS_WAIT() asm volatile("s_waitcnt lgkmcnt(0)" ::: "memory")
#define VM_WAIT() asm volatile("s_waitcnt vmcnt(0)" ::: "memory")
__device__ __forceinline__ float bf2f(unsigned b) { return __uint_as_float(b << 16); }
__device__ __forceinline__ float bflo(unsigned w) { return __uint_as_float(w << 16); }
__device__ __forceinline__ float bfhi(unsigned w) { return __uint_as_float(w & 0xffff0000u); }
__device__ __forceinline__ unsigned f2bf(float f) { unsigned u = __float_as_uint(f); return (u + 0x7fffu + ((u >> 16) & 1u)) >> 16; }
__device__ __forceinline__ unsigned pk2(float lo, float hi) { return f2bf(lo) | (f2bf(hi) << 16); }
__device__ __forceinline__ float wave_sum(float v) {
#pragma unroll
    for (int o = 1; o < 64; o <<= 1) v += __shfl_xor(v, o);
    return v;
}
__device__ __forceinline__ float log_sigmoid(float z) { return fminf(z, 0.f) - log1pf(expf(-fabsf(z))); }

struct Ctx { LAS unsigned char* lds; int tid, lane, wave, bid, G; };
namespace pg8 {
#define PG8_LAS __attribute__((address_space(3)))
typedef unsigned short bf16_t;
typedef short bf16x8 __attribute__((ext_vector_type(8)));
typedef float f32x4 __attribute__((ext_vector_type(4)));
typedef unsigned u32x4 __attribute__((ext_vector_type(4)));
constexpr int BM = 256, BK = 64, HALF = 128, HTB = HALF * BK * 2  , STAGE_BYTES = 8 * HTB, NXCD = 8, WGM = 8;

__host__ __device__ __forceinline__ int lds_byte(int r, int c) { const int st = (r >> 4) * 2 + (c >> 5), rr = r & 15, cc = c & 31, ob = rr * 64 + cc * 2; return st * 1024 + (ob ^ (((ob >> 9) & 1) << 5)); }
__host__ __device__ __forceinline__ void stage_rc(int b, int& R, int& C) { const int st = b / 1024, sb = b % 1024, swz = sb ^ (((sb >> 9) & 1) << 5); R = (st >> 1) * 16 + swz / 64; C = (st & 1) * 32 + (swz % 64) / 2; }
__host__ __device__ __forceinline__ int perm32(int rho) { const int n = rho >> 4, i = rho & 15; return 8 * (i >> 2) + 4 * n + (i & 3); }

struct Unit { int pm, pn; };
struct Gemm { const bf16_t* A; const bf16_t* Bt; int M, N, K; };

struct StaticOrder {
    int nM, nN, nwg, G, c;
    __host__ __device__ void init(int M, int N, int G_, int c_) { nM = M / BM; nN = N / BM; nwg = nM * nN; G = G_; c = c_; }
    __host__ __device__ bool next(int i, Unit& u) const {
        const long L = (long)i * G + c; if (L >= nwg) return false;
        int wgid = (int)L; { const int q = nwg / NXCD, r = nwg % NXCD, xcd = wgid % NXCD, off = wgid / NXCD; wgid = (xcd < r ? xcd * (q + 1) : r * (q + 1) + (xcd - r) * q) + off; }
        const int nig = WGM * nN, gid = wgid / nig, fm = gid * WGM, gsz = (nM - fm) < WGM ? (nM - fm) : WGM;
        u.pm = fm + ((wgid % nig) % gsz); u.pn = (wgid % nig) / gsz; return true;
    }
    __device__ __forceinline__ void a_ready(const Unit&) const {}
    __device__ __forceinline__ void done(const Unit&) const {}
};

__device__ __forceinline__ unsigned cvt_pk_bf16(float lo, float hi) { unsigned r; asm volatile("v_cvt_pk_bf16_f32 %0, %1, %2" : "=v"(r) : "v"(lo), "v"(hi)); return r; }

struct EpiStoreBf16 {
    static constexpr bool PERM = true, AFTER_DRAIN = false; __device__ __forceinline__ bool perm() const { return true; }
    bf16_t* O; int ldc;
    __device__ __forceinline__ void operator()(const f32x4 (&acc)[2][2][4][2], const Unit& u, int wr, int wc, int fr, int fq) const {
        const int row0 = u.pm * BM + wr * 64 + fr, col0 = u.pn * BM + wc * 32 + 8 * fq;
#pragma unroll
        for (int ai = 0; ai < 2; ++ai)
#pragma unroll
            for (int m = 0; m < 4; ++m) { bf16_t* rowp = O + (size_t)(row0 + ai * HALF + m * 16) * ldc + col0;
#pragma unroll
                for (int bj = 0; bj < 2; ++bj) { const f32x4 v0 = acc[ai][bj][m][0], v1 = acc[ai][bj][m][1];
                    u32x4 w; w.x = cvt_pk_bf16(v0[0], v0[1]); w.y = cvt_pk_bf16(v0[2], v0[3]); w.z = cvt_pk_bf16(v1[0], v1[1]); w.w = cvt_pk_bf16(v1[2], v1[3]);
                    *(u32x4*)(rowp + bj * HALF) = w; } }
    }
};
struct EpiResidF32 {
    static constexpr bool PERM = false, AFTER_DRAIN = false; __device__ __forceinline__ bool perm() const { return false; }
    const float* base; float* out; int ldc;
    __device__ __forceinline__ void operator()(const f32x4 (&acc)[2][2][4][2], const Unit& u, int wr, int wc, int fr, int fq) const {
        const int row0 = u.pm * BM + wr * 64 + fr, col0 = u.pn * BM + wc * 32 + 4 * fq;
#pragma unroll
        for (int ai = 0; ai < 2; ++ai)
#pragma unroll
            for (int m = 0; m < 4; ++m) { const size_t off = (size_t)(row0 + ai * HALF + m * 16) * ldc + col0;
#pragma unroll
                for (int bj = 0; bj < 2; ++bj)
#pragma unroll
                    for (int n = 0; n < 2; ++n) { const f32x4 bs = *(const f32x4*)(base + off + bj * HALF + n * 16); *(f32x4*)(out + off + bj * HALF + n * 16) = bs + acc[ai][bj][m][n]; }
                asm volatile("" ::: "memory"); }
    }
};
__device__ __forceinline__ float silu_mul(float g, float u) { return g * u * __builtin_amdgcn_rcpf(1.0f + __builtin_amdgcn_exp2f(-1.4426950408889634f * g)); }
struct EpiSwiGLU {
    static constexpr bool PERM = true, AFTER_DRAIN = false; __device__ __forceinline__ bool perm() const { return true; }
    bf16_t* O; int ldc;
    __device__ __forceinline__ void operator()(const f32x4 (&acc)[2][2][4][2], const Unit& u, int wr, int wc, int fr, int fq) const {
        const int row0 = u.pm * BM + wr * 64 + fr, col0 = u.pn * HALF + wc * 32 + 8 * fq;
#pragma unroll
        for (int ai = 0; ai < 2; ++ai)
#pragma unroll
            for (int m = 0; m < 4; ++m) { bf16_t* rowp = O + (size_t)(row0 + ai * HALF + m * 16) * ldc + col0;
                const f32x4 g0 = acc[ai][0][m][0], g1 = acc[ai][0][m][1], u0 = acc[ai][1][m][0], u1 = acc[ai][1][m][1];
                u32x4 w; w.x = cvt_pk_bf16(silu_mul(g0[0], u0[0]), silu_mul(g0[1], u0[1])); w.y = cvt_pk_bf16(silu_mul(g0[2], u0[2]), silu_mul(g0[3], u0[3]));
                w.z = cvt_pk_bf16(silu_mul(g1[0], u1[0]), silu_mul(g1[1], u1[1])); w.w = cvt_pk_bf16(silu_mul(g1[2], u1[2]), silu_mul(g1[3], u1[3]));
                *(u32x4*)rowp = w; }
    }
};
struct EpiAny {
    static constexpr bool AFTER_DRAIN = false;
    int mode; bf16_t* O; const float* base; float* out; int ldc;
    __device__ __forceinline__ bool perm() const { return mode != 1; }
    __device__ __forceinline__ void operator()(const f32x4 (&acc)[2][2][4][2], const Unit& u, int wr, int wc, int fr, int fq) const {
        if (mode == 0) { EpiStoreBf16 e{O, ldc}; e(acc, u, wr, wc, fr, fq); }
        else if (mode == 1) { EpiResidF32 e{base, out, ldc}; e(acc, u, wr, wc, fr, fq); }
        else { EpiSwiGLU e{O, ldc}; e(acc, u, wr, wc, fr, fq); }
    }
};
template <class Epi, class Sched, bool ALIGN_EPI = false, bool SP2 = false>
__device__ __forceinline__ void gemm_phase(PG8_LAS unsigned char* lds, const Gemm g, const Sched& S, const Epi& E) {
    const int tid = threadIdx.x, wid = __builtin_amdgcn_readfirstlane(tid >> 6), lane = tid & 63, wr = wid >> 2, wc = wid & 3, fr = lane & 15, fq = lane >> 4;
    const int K = g.K, nt = K / BK;
    unsigned voffA[2], voffB[2];
#pragma unroll
    for (int i = 0; i < 2; ++i) { int R, C; stage_rc(tid * 16 + i * 8192, R, C); const int Rb = E.perm() ? ((R & ~31) + perm32(R & 31)) : R;
        voffA[i] = (unsigned)(R * K + C) * 2u; voffB[i] = (unsigned)(Rb * K + C) * 2u; }
    const size_t kstep = (size_t)(BK * 2);
    const size_t hstep = (size_t)HALF * K * 2;
    const size_t tstep = 2 * hstep;
    const unsigned ldsw = (unsigned)wid * 1024u;
    const int aoff = lds_byte(wr * 64 + fr, fq * 8), boff = lds_byte(wc * 32 + fr, fq * 8);
#define PG8_SA(b, h) (((b) * 2 + (h)) * HTB)
#define PG8_SB(b, h) ((4 + (b) * 2 + (h)) * HTB)
#define PG8_STAGE(bufoff, gbase, voff) do { _Pragma("unroll") for (int _i = 0; _i < 2; ++_i) \
        __builtin_amdgcn_global_load_lds((const unsigned*)((const char*)(gbase) + (voff)[_i]), (PG8_LAS unsigned*)(lds + (bufoff) + ldsw + _i * 8192), 16, 0, 0); } while (0)
#define PG8_LDA(dst, b, h) do { _Pragma("unroll") for (int m = 0; m < 4; ++m) _Pragma("unroll") for (int k = 0; k < 2; ++k) dst[m][k] = *(const PG8_LAS bf16x8*)(lds + PG8_SA(b, h) + aoff + m * 2048 + k * 1024); } while (0)
#define PG8_LDB(dst, b, h) do { _Pragma("unroll") for (int n = 0; n < 2; ++n) _Pragma("unroll") for (int k = 0; k < 2; ++k) dst[n][k] = *(const PG8_LAS bf16x8*)(lds + PG8_SB(b, h) + boff + n * 2048 + k * 1024); } while (0)
#define PG8_MMA(ai, bj, At, Bt) do { __builtin_amdgcn_s_setprio(1); _Pragma("unroll") for (int m = 0; m < 4; ++m) _Pragma("unroll") for (int n = 0; n < 2; ++n) _Pragma("unroll") for (int k = 0; k < 2; ++k) \
        acc[ai][bj][m][n] = __builtin_amdgcn_mfma_f32_16x16x32_bf16(Bt[n][k], At[m][k], acc[ai][bj][m][n], 0, 0, 0); __builtin_amdgcn_s_setprio(0); } while (0)
#define PG8_WAIT_V(n) asm volatile("s_waitcnt vmcnt(" #n ")" ::: "memory")
#define PG8_WAIT_L(n) asm volatile("s_waitcnt lgkmcnt(" #n ")" ::: "memory")
#define PG8_BAR __builtin_amdgcn_s_barrier()
#define PG8_SCHED __builtin_amdgcn_sched_barrier(0)
    Unit cur, nxt; int ui = 0;
    if (!S.next(0, cur)) return;
    f32x4 acc[2][2][4][2];
#pragma unroll
    for (int a = 0; a < 2; ++a)
#pragma unroll
        for (int b = 0; b < 2; ++b)
#pragma unroll
            for (int m = 0; m < 4; ++m)
#pragma unroll
                for (int n = 0; n < 2; ++n) acc[a][b][m][n] = (f32x4){0.f, 0.f, 0.f, 0.f};
    bf16x8 At[4][2], B0[2][2], B1[2][2];
    const char* cA = (const char*)g.A + (size_t)cur.pm * tstep; const char* cB = (const char*)g.Bt + (size_t)cur.pn * tstep;
    S.a_ready(cur);
    if constexpr (SP2) {
        PG8_STAGE(PG8_SB(0, 0), cB, voffB); PG8_STAGE(PG8_SB(0, 1), cB + hstep, voffB); PG8_STAGE(PG8_SA(0, 0), cA, voffA); PG8_STAGE(PG8_SA(0, 1), cA + hstep, voffA);
        if (wr == 1) PG8_BAR;
        PG8_WAIT_V(2); PG8_BAR;
        PG8_STAGE(PG8_SB(1, 0), cB + kstep, voffB); PG8_STAGE(PG8_SA(1, 0), cA + kstep, voffA); PG8_STAGE(PG8_SB(1, 1), cB + hstep + kstep, voffB);
        PG8_WAIT_V(6); PG8_BAR;
    } else {
        PG8_STAGE(PG8_SB(0, 0), cB, voffB); PG8_STAGE(PG8_SA(0, 0), cA, voffA); PG8_STAGE(PG8_SB(0, 1), cB + hstep, voffB); PG8_STAGE(PG8_SA(0, 1), cA + hstep, voffA);
        if (wr == 1) PG8_BAR;
        PG8_WAIT_V(4); PG8_BAR;
        PG8_STAGE(PG8_SB(1, 0), cB + kstep, voffB); PG8_STAGE(PG8_SA(1, 0), cA + kstep, voffA); PG8_STAGE(PG8_SB(1, 1), cB + hstep + kstep, voffB);
        PG8_WAIT_V(6); PG8_BAR;
    }
    for (;;) {
        const bool has_next = S.next(ui + 1, nxt);
        const char* nA = has_next ? (const char*)g.A + (size_t)nxt.pm * tstep : cA; const char* nB = has_next ? (const char*)g.Bt + (size_t)nxt.pn * tstep : cB;
        for (int t = 0; t < nt; t += 2) {
            const bool last = (t == nt - 2);
            const char* a1 = cA + (size_t)(t + 1) * kstep;
            const char* a2 = last ? nA : cA + (size_t)(t + 2) * kstep; const char* b2 = last ? nB : cB + (size_t)(t + 2) * kstep;
            const char* a3 = a2 + kstep; const char* b3 = b2 + kstep;
            if (last && has_next) S.a_ready(nxt);
            if constexpr (SP2) {
            PG8_LDB(B0, 0, 0); PG8_LDB(B1, 0, 1); PG8_SCHED; PG8_LDA(At, 0, 0); PG8_STAGE(PG8_SA(1, 1), a1 + hstep, voffA);
            PG8_WAIT_V(8); PG8_WAIT_L(0); PG8_BAR; PG8_MMA(0, 0, At, B0); PG8_MMA(0, 1, At, B1); PG8_BAR; PG8_SCHED;
            PG8_LDA(At, 0, 1); PG8_STAGE(PG8_SB(0, 0), b2, voffB); PG8_STAGE(PG8_SB(0, 1), b2 + hstep, voffB); PG8_STAGE(PG8_SA(0, 0), a2, voffA);
            PG8_WAIT_V(8); PG8_WAIT_L(0); PG8_BAR; PG8_MMA(1, 0, At, B0); PG8_MMA(1, 1, At, B1); PG8_BAR; PG8_SCHED;
            PG8_LDB(B0, 1, 0); PG8_LDB(B1, 1, 1); PG8_SCHED; PG8_LDA(At, 1, 0); PG8_STAGE(PG8_SA(0, 1), a2 + hstep, voffA);
            PG8_WAIT_V(8); PG8_WAIT_L(0); PG8_BAR; PG8_MMA(0, 0, At, B0); PG8_MMA(0, 1, At, B1); PG8_BAR; PG8_SCHED;
            PG8_LDA(At, 1, 1); PG8_STAGE(PG8_SB(1, 0), b3, voffB); PG8_STAGE(PG8_SB(1, 1), b3 + hstep, voffB); PG8_STAGE(PG8_SA(1, 0), a3, voffA);
            PG8_WAIT_V(8); PG8_WAIT_L(0); PG8_BAR; PG8_MMA(1, 0, At, B0); PG8_MMA(1, 1, At, B1); PG8_BAR; PG8_SCHED;
            } else {
            PG8_LDB(B0, 0, 0); PG8_SCHED; PG8_LDA(At, 0, 0); PG8_STAGE(PG8_SA(1, 1), a1 + hstep, voffA);
            PG8_WAIT_L(8); PG8_BAR; PG8_WAIT_L(0); PG8_MMA(0, 0, At, B0); PG8_BAR; PG8_SCHED;
            PG8_LDB(B1, 0, 1); PG8_STAGE(PG8_SB(0, 0), b2, voffB);
            PG8_BAR; PG8_WAIT_L(0); PG8_MMA(0, 1, At, B1); PG8_BAR;
            PG8_LDA(At, 0, 1); PG8_STAGE(PG8_SA(0, 0), a2, voffA);
            PG8_BAR; PG8_WAIT_L(0); PG8_MMA(1, 0, At, B0); PG8_BAR; PG8_SCHED;
            PG8_STAGE(PG8_SB(0, 1), b2 + hstep, voffB);
            PG8_WAIT_V(6); PG8_BAR; PG8_MMA(1, 1, At, B1); PG8_BAR;
            PG8_LDB(B0, 1, 0); PG8_SCHED; PG8_LDA(At, 1, 0); PG8_STAGE(PG8_SA(0, 1), a2 + hstep, voffA);
            PG8_WAIT_L(8); PG8_BAR; PG8_WAIT_L(0); PG8_MMA(0, 0, At, B0); PG8_BAR; PG8_SCHED;
            PG8_LDB(B1, 1, 1); PG8_STAGE(PG8_SB(1, 0), b3, voffB);
            PG8_BAR; PG8_WAIT_L(0); PG8_MMA(0, 1, At, B1); PG8_BAR;
            PG8_LDA(At, 1, 1); PG8_STAGE(PG8_SA(1, 0), a3, voffA);
            PG8_BAR; PG8_WAIT_L(0); PG8_MMA(1, 0, At, B0); PG8_BAR; PG8_SCHED;
            PG8_STAGE(PG8_SB(1, 1), b3 + hstep, voffB);
            PG8_WAIT_V(6); PG8_BAR; PG8_MMA(1, 1, At, B1); PG8_BAR;
            }
        }
        if constexpr (ALIGN_EPI) { if (wr == 0) PG8_BAR; }
        if constexpr (!Epi::AFTER_DRAIN) { E(acc, cur, wr, wc, fr, fq); S.done(cur); }
        if (!has_next) break;
#pragma unroll
        for (int a = 0; a < 2; ++a)
#pragma unroll
            for (int b = 0; b < 2; ++b)
#pragma unroll
                for (int m = 0; m < 4; ++m)
#pragma unroll
                    for (int n = 0; n < 2; ++n) acc[a][b][m][n] = (f32x4){0.f, 0.f, 0.f, 0.f};
        cur = nxt; cA = nA; cB = nB; ++ui;
        if constexpr (ALIGN_EPI) { if (wr == 1) PG8_BAR; }
    }
    PG8_WAIT_V(0);
    if constexpr (!ALIGN_EPI) { if (wr == 0) PG8_BAR; }
    PG8_BAR;
    if constexpr (Epi::AFTER_DRAIN) { E.fused(acc, cur, wr, wc, fr, fq, lds, wid, lane); S.done(cur); }
#undef PG8_SA
#undef PG8_SB
#undef PG8_STAGE
#undef PG8_LDA
#undef PG8_LDB
#undef PG8_MMA
#undef PG8_WAIT_V
#undef PG8_WAIT_L
#undef PG8_BAR
#undef PG8_SCHED
}
}
__device__ __forceinline__ bf16* ws_wt(const Params& P, int l, size_t off) { return (bf16*)(P.ws + WS_WT + (size_t)l * WT_STRIDE + off); }
__device__ __forceinline__ bf16* ws_h(const Params& P) { return (bf16*)(P.ws + WS_H); }
__device__ __forceinline__ bf16* ws_proj(const Params& P) { return (bf16*)(P.ws + WS_PROJ); }
__device__ __forceinline__ bf16* ws_ff(const Params& P) { return (bf16*)(P.ws + WS_PROJ); }
__device__ __forceinline__ bf16* ws_mixed(const Params& P) { return (bf16*)(P.ws + WS_MIXED); }
__device__ __forceinline__ float* ws_ga(const Params& P) { return (float*)(P.ws + WS_GA); }

__device__ __forceinline__ void transpose_item(const float* W, int ldw, int col0, int ncols, bf16* WT, int ldt, int drow0, int k0, LAS float* scr, int lane) {
#pragma unroll 8
    for (int i = 0; i < 32; ++i) { const int kk = 2 * i + (lane >> 5), c = lane & 31; scr[kk * 33 + c] = (c < ncols) ? W[(size_t)(k0 + kk) * ldw + col0 + c] : 0.f; }
    LDS_WAIT();
    const int c8 = lane & 7;
#pragma unroll
    for (int j = 0; j < 4; ++j) { const int n = (lane >> 3) + 8 * j; const LAS float* s = scr + (8 * c8) * 33 + n;
        u32x4 o; o.x = pk2(s[0 * 33], s[1 * 33]); o.y = pk2(s[2 * 33], s[3 * 33]); o.z = pk2(s[4 * 33], s[5 * 33]); o.w = pk2(s[6 * 33], s[7 * 33]);
        if (n < ncols) *(u32x4*)(WT + (size_t)(drow0 + n) * ldt + k0 + 8 * c8) = o; }
    LDS_WAIT();
}
constexpr int CV_IN = 161 * 32, CV_OUT = 64 * 32, CV_GU = 176 * 32, CV_DN = 64 * 88, CV_PW = 32, CV_LAYER = CV_IN + CV_OUT + 3 * CV_GU + CV_PW;
static_assert(CV_GU == CV_DN, "gate/up/down item counts");
__device__ __forceinline__ void ph_convert(const Params& P, const Ctx& C) {
    LAS float* scr = (LAS float*)(C.lds + C.wave * 8704);
    const int gw = C.bid * 8 + C.wave, NGW = C.G * 8;
    for (int it = gw; it < DEPTH * CV_LAYER; it += NGW) {
        const int l = it / CV_LAYER; int r = it % CV_LAYER;
        if (r < CV_IN) { const int nb = r % 161, kb = r / 161; int col0, drow0, nc = 32;
            if (nb < 144) { col0 = 32 * nb; drow0 = 32 * nb; } else if (nb < 160) { col0 = 4624 + 32 * (nb - 144); drow0 = 4608 + 32 * (nb - 144); } else { col0 = 4608; drow0 = NPROJ; nc = 16; }
            transpose_item(P.w_in + (size_t)l * D_MODEL * IN_COLS, IN_COLS, col0, nc, ws_wt(P, l, WT_IN), D_MODEL, drow0, 64 * kb, scr, C.lane); continue; }
        r -= CV_IN;
        if (r < CV_OUT) { const int nb = r % 64, kb = r / 64;
            transpose_item(P.w_out + (size_t)l * D_MODEL * D_MODEL, D_MODEL, 32 * nb, 32, ws_wt(P, l, WT_OUT), D_MODEL, 32 * nb, 64 * kb, scr, C.lane); continue; }
        r -= CV_OUT;
        if (r < 2 * CV_GU) { const int up = r >= CV_GU; if (up) r -= CV_GU; const int nb = r % 176, kb = r / 176;
            transpose_item((up ? P.w_up : P.w_gate) + (size_t)l * D_MODEL * DFF, DFF, 32 * nb, 32, ws_wt(P, l, WT_GU), D_MODEL, 256 * (nb >> 2) + 32 * (nb & 3) + (up ? 128 : 0), 64 * kb, scr, C.lane); continue; }
        r -= 2 * CV_GU;
        if (r < CV_DN) { const int nb = r % 64, kb = r / 64;
            transpose_item(P.w_down + (size_t)l * DFF * D_MODEL, D_MODEL, 32 * nb, 32, ws_wt(P, l, WT_DN), DFF, 32 * nb, 64 * kb, scr, C.lane); continue; }
        r -= CV_DN;
        { const int g = r >> 3, nb = r & 3, kb = (r >> 2) & 1;
            transpose_item(P.pool_w + (size_t)(l * 4 + g) * 128 * 128, 128, 32 * nb, 32, ws_wt(P, l, WT_PW) + (size_t)g * 128 * 128, 128, 32 * nb, 64 * kb, scr, C.lane); }
    }
}

__device__ __forceinline__ void ph_rmsnorm(const float* x, const float* g, bf16* h, const Ctx& C) {
    const int gw = C.bid * 8 + C.wave, NGW = C.G * 8;
    for (int m = gw; m < MTOK; m += NGW) {
        const f32x4* xr = (const f32x4*)(x + (size_t)m * D_MODEL) + C.lane;
        f32x4 v[8]; float s = 0.f;
#pragma unroll
        for (int j = 0; j < 8; ++j) { v[j] = xr[64 * j]; s += (v[j].x * v[j].x + v[j].y * v[j].y) + (v[j].z * v[j].z + v[j].w * v[j].w); }
        const float rstd = 1.0f / sqrtf(wave_sum(s) * (1.0f / D_MODEL) + RMS_EPS);
        u32x2* o8 = (u32x2*)(h + (size_t)m * D_MODEL) + C.lane;
#pragma unroll
        for (int j = 0; j < 8; ++j) { const f32x4 gg = ((const f32x4*)g)[C.lane + 64 * j];
            u32x2 w; w.x = pk2(v[j].x * rstd * gg.x, v[j].y * rstd * gg.y); w.y = pk2(v[j].z * rstd * gg.z, v[j].w * rstd * gg.w); o8[64 * j] = w; }
    }
}

__device__ __forceinline__ float dot8_bf16(const u32x4 a, const u32x4 b) {
    return bflo(a.x) * bflo(b.x) + bfhi(a.x) * bfhi(b.x) + bflo(a.y) * bflo(b.y) + bfhi(a.y) * bfhi(b.y) + bflo(a.z) * bflo(b.z) + bfhi(a.z) * bfhi(b.z) + bflo(a.w) * bflo(b.w) + bfhi(a.w) * bfhi(b.w);
}
__device__ __forceinline__ void ph_ga_naive(const Params& P, int l, const Ctx& C) {
    const bf16* h = ws_h(P); const bf16* wa = ws_wt(P, l, WT_IN) + (size_t)NPROJ * D_MODEL; float* ga = ws_ga(P);
    const int gw = C.bid * 8 + C.wave, NGW = C.G * 8;
    for (int m = gw; m < MTOK; m += NGW) {
        float acc[16];
#pragma unroll
        for (int j = 0; j < 16; ++j) acc[j] = 0.f;
#pragma unroll 1
        for (int i = 0; i < 4; ++i) {
            const u32x4 hv = *(const u32x4*)(h + (size_t)m * D_MODEL + 8 * C.lane + 512 * i);
#pragma unroll
            for (int j = 0; j < 16; ++j) { const u32x4 wv = *(const u32x4*)(wa + (size_t)j * D_MODEL + 8 * C.lane + 512 * i); acc[j] += dot8_bf16(hv, wv); }
        }
        float val = 0.f;
#pragma unroll
        for (int j = 0; j < 16; ++j) { const float s = wave_sum(acc[j]); val = (C.lane == j) ? s : val; }
        if (C.lane < 16) ga[(size_t)m * 16 + C.lane] = val;
    }
}

__device__ __forceinline__ void ph_conv(const Params& P, int l, const Ctx& C) {
    const bf16* proj = ws_proj(P); bf16* mixed = ws_mixed(P); const float* cw = P.conv_w + (size_t)l * 3 * GW;
    for (int it = C.bid * 512 + C.tid; it < MTOK * 64; it += C.G * 512) {
        const int m = it >> 6, c8 = (it & 63) * 8, t = m & (SEQ - 1);
        float acc[8];
#pragma unroll
        for (int e = 0; e < 8; ++e) acc[e] = 0.f;
#pragma unroll
        for (int i = 0; i < 3; ++i) { if (t - 2 + i >= 0) {
            const u32x4 cc = *(const u32x4*)(proj + (size_t)(m - 2 + i) * NPROJ + PC_CC + c8), hh = *(const u32x4*)(proj + (size_t)(m - 2 + i) * NPROJ + PC_CH + c8);
            const f32x4 w0 = *(const f32x4*)(cw + i * GW + c8), w1 = *(const f32x4*)(cw + i * GW + c8 + 4);
            acc[0] += w0.x * bflo(cc.x) * bflo(hh.x); acc[1] += w0.y * bfhi(cc.x) * bfhi(hh.x); acc[2] += w0.z * bflo(cc.y) * bflo(hh.y); acc[3] += w0.w * bfhi(cc.y) * bfhi(hh.y);
            acc[4] += w1.x * bflo(cc.z) * bflo(hh.z); acc[5] += w1.y * bfhi(cc.z) * bfhi(hh.z); acc[6] += w1.z * bflo(cc.w) * bflo(hh.w); acc[7] += w1.w * bfhi(cc.w) * bfhi(hh.w); } }
        const u32x4 bb = *(const u32x4*)(proj + (size_t)m * NPROJ + PC_CB + c8);
        u32x4 o; o.x = pk2(bflo(bb.x) * acc[0], bfhi(bb.x) * acc[1]); o.y = pk2(bflo(bb.y) * acc[2], bfhi(bb.y) * acc[3]); o.z = pk2(bflo(bb.z) * acc[4], bfhi(bb.z) * acc[5]); o.w = pk2(bflo(bb.w) * acc[6], bfhi(bb.w) * acc[7]);
        *(u32x4*)(mixed + (size_t)m * D_MODEL + MC_CONV + c8) = o;
    }
}

__device__ __forceinline__ void ph_pool_naive(const Params& P, int l, const Ctx& C) {
    const bf16* proj = ws_proj(P); bf16* mixed = ws_mixed(P);
    LAS float* Ps = (LAS float*)C.lds;
    for (int unit = C.bid; unit < 256 * 4; unit += C.G) {
        const int g = unit & 3, m0 = (unit >> 2) * 64, w = 2 << g;
        __syncthreads();
        { const int c = C.tid & 127, tq = C.tid >> 7;
          for (int tk = 0; tk < 16; ++tk) { const int m = m0 + 16 * tq + tk, t = m & (SEQ - 1), cnt = (t + 1 < w) ? t + 1 : w; float s = 0.f;
              for (int i = 0; i < cnt; ++i) s += bf2f(proj[(size_t)(m - i) * NPROJ + PC_PU + g * 128 + c]);
              Ps[(16 * tq + tk) * 128 + c] = s / (float)cnt - bf2f(proj[(size_t)m * NPROJ + PC_PU + g * 128 + c]); } }
        __syncthreads();
        { const int d = C.tid & 127, tq = C.tid >> 7; const float* pw = P.pool_w + (size_t)(l * 4 + g) * 128 * 128; float acc[16];
#pragma unroll
          for (int tk = 0; tk < 16; ++tk) acc[tk] = 0.f;
          for (int c = 0; c < 128; ++c) { const float wv = pw[c * 128 + d];
#pragma unroll
              for (int tk = 0; tk < 16; ++tk) acc[tk] += Ps[(16 * tq + tk) * 128 + c] * wv; }
          const float sc = P.pool_scale[l * GW + g * 128 + d];
#pragma unroll
          for (int tk = 0; tk < 16; ++tk) mixed[(size_t)(m0 + 16 * tq + tk) * D_MODEL + MC_POOL + g * 128 + d] = (bf16)f2bf(acc[tk] * sc); }
    }
}

__device__ __forceinline__ void ph_sb_naive(const Params& P, int l, const Ctx& C) {
    const bf16* proj = ws_proj(P); bf16* mixed = ws_mixed(P);
    LAS float* Ks = (LAS float*)C.lds;
    LAS float* Vs = Ks + 64 * 129;
    LAS float* Qs = Vs + 64 * 128;
    const float* qg = P.sb_q_g + l * 128; const float* kg = P.sb_k_g + l * 128;
    const int w = C.wave, lane = C.lane;
    for (int unit = C.bid; unit < 32 * 256; unit += C.G) {
        const int bh = unit >> 8, tg = unit & 255, b = bh >> 2, h = bh & 3, t0 = 8 * tg; const size_t mrow0 = (size_t)b * SEQ;
        __syncthreads();
        { const unsigned q2 = *(const unsigned*)(proj + (mrow0 + t0 + w) * NPROJ + PC_SQ + h * 128 + 2 * lane); const float qa = bflo(q2), qb = bfhi(q2);
          const float r = 1.0f / sqrtf(wave_sum(qa * qa + qb * qb) * (1.0f / 128.f) + RMS_EPS) * 0.08838834764831845f;
          Qs[w * 128 + 2 * lane] = qa * r * qg[2 * lane]; Qs[w * 128 + 2 * lane + 1] = qb * r * qg[2 * lane + 1]; }
        const int t = t0 + w; float carry = 0.f, o0 = 0.f, o1 = 0.f;
        const int nkb = (t0 + 6) / 64 + 1;
        for (int kb = nkb - 1; kb >= 0; --kb) {
            __syncthreads();
            for (int rr = 0; rr < 8; ++rr) { const int r = 8 * w + rr; const size_t mrow = mrow0 + kb * 64 + r;
                const unsigned k2 = *(const unsigned*)(proj + mrow * NPROJ + PC_SK + h * 128 + 2 * lane), v2 = *(const unsigned*)(proj + mrow * NPROJ + PC_SV + h * 128 + 2 * lane);
                const float ka = bflo(k2), kb2 = bfhi(k2); const float rs = 1.0f / sqrtf(wave_sum(ka * ka + kb2 * kb2) * (1.0f / 128.f) + RMS_EPS);
                Ks[r * 129 + 2 * lane] = ka * rs * kg[2 * lane]; Ks[r * 129 + 2 * lane + 1] = kb2 * rs * kg[2 * lane + 1];
                Vs[r * 128 + 2 * lane] = bflo(v2); Vs[r * 128 + 2 * lane + 1] = bfhi(v2); }
            __syncthreads();
            const int s = kb * 64 + lane; const bool valid = s < t;
            float z = 0.f;
#pragma unroll 8
            for (int d = 0; d < 128; ++d) z += Qs[w * 128 + d] * Ks[lane * 129 + d];
            const float ls = log_sigmoid(z), lr = valid ? ls - z : 0.f;
            float incl = lr;
#pragma unroll
            for (int o = 1; o < 64; o <<= 1) { const float tmp = __shfl_down(incl, o); if (lane + o < 64) incl += tmp; }
            const float sfx = incl - lr, total = __shfl(incl, 0);
            const float a = valid ? expf(ls + sfx + carry) : 0.f;
            carry += total;
#pragma unroll 8
            for (int j = 0; j < 64; ++j) { const float aj = __shfl(a, j); o0 += aj * Vs[j * 128 + lane]; o1 += aj * Vs[j * 128 + lane + 64]; }
        }
        bf16* orow = mixed + (mrow0 + t) * D_MODEL + MC_SB + h * 128;
        orow[lane] = (bf16)f2bf(o0); orow[lane + 64] = (bf16)f2bf(o1);
    }
}

__device__ __forceinline__ void ph_gla_naive(const Params& P, int l, const Ctx& C) {
    const bf16* proj = ws_proj(P); bf16* mixed = ws_mixed(P); const float* ga = ws_ga(P);
    LAS float* Qs = (LAS float*)C.lds;
    LAS float* Ks = Qs + 4096;
    LAS float* Fs = Ks + 4096;
    LAS float* Vs = Fs + 4096;
    LAS float* Os = Vs + 8192;
    LAS float* Gs = Os + 8192;
    LAS float* AW = Gs + 1024;
    LAS float* AB = AW + 1024;
    const int tid = C.tid, lane = C.lane, w = C.wave, kq = lane >> 4, v16 = lane & 15;
    const float* ng = P.gla_norm_g + l * 128;
    for (int unit = C.bid; unit < 32; unit += C.G) {
        const int b = unit >> 2, h = unit & 3;
        __syncthreads();
        for (int i = tid; i < 1024; i += 512) AW[i] = P.gla_a_w[(size_t)l * 16 * 256 + (i >> 6) * 256 + h * 64 + (i & 63)];
        if (tid < 64) AB[tid] = P.gla_a_b[l * 256 + h * 64 + tid];
        float S[16];
#pragma unroll
        for (int i = 0; i < 16; ++i) S[i] = 0.f;
        for (int c = 0; c < 32; ++c) {
            const size_t m0 = (size_t)b * SEQ + 64 * c;
            __syncthreads();
            { const int row = tid >> 3, c8 = (tid & 7) * 8;
              const u32x4 q4 = *(const u32x4*)(proj + (m0 + row) * NPROJ + PC_GQ + h * 64 + c8), k4 = *(const u32x4*)(proj + (m0 + row) * NPROJ + PC_GK + h * 64 + c8);
              LAS float* qd = Qs + row * 64 + c8; LAS float* kd = Ks + row * 64 + c8;
              qd[0] = bflo(q4.x) * 0.125f; qd[1] = bfhi(q4.x) * 0.125f; qd[2] = bflo(q4.y) * 0.125f; qd[3] = bfhi(q4.y) * 0.125f; qd[4] = bflo(q4.z) * 0.125f; qd[5] = bfhi(q4.z) * 0.125f; qd[6] = bflo(q4.w) * 0.125f; qd[7] = bfhi(q4.w) * 0.125f;
              kd[0] = bflo(k4.x); kd[1] = bfhi(k4.x); kd[2] = bflo(k4.y); kd[3] = bfhi(k4.y); kd[4] = bflo(k4.z); kd[5] = bfhi(k4.z); kd[6] = bflo(k4.w); kd[7] = bfhi(k4.w);
              const int c16 = (tid & 7) * 16;
#pragma unroll
              for (int hh = 0; hh < 2; ++hh) { const u32x4 v4 = *(const u32x4*)(proj + (m0 + row) * NPROJ + PC_GV + h * 128 + c16 + 8 * hh); LAS float* vd = Vs + row * 128 + c16 + 8 * hh;
                  vd[0] = bflo(v4.x); vd[1] = bfhi(v4.x); vd[2] = bflo(v4.y); vd[3] = bfhi(v4.y); vd[4] = bflo(v4.z); vd[5] = bfhi(v4.z); vd[6] = bflo(v4.w); vd[7] = bfhi(v4.w); }
              if (tid < 256) { const f32x4 g4 = *(const f32x4*)(ga + (m0 + (tid >> 2)) * 16 + (tid & 3) * 4); LAS float* gd = Gs + (tid >> 2) * 16 + (tid & 3) * 4; gd[0] = g4.x; gd[1] = g4.y; gd[2] = g4.z; gd[3] = g4.w; } }
            __syncthreads();
            { const int row = tid >> 3, k8 = (tid & 7) * 8;
#pragma unroll
              for (int e = 0; e < 8; ++e) { const int k = k8 + e; float lg = AB[k];
#pragma unroll
                  for (int j = 0; j < 16; ++j) lg += Gs[row * 16 + j] * AW[j * 64 + k];
                  Fs[row * 64 + k] = expf(log_sigmoid(lg) * (1.0f / 16.0f)); } }
            __syncthreads();
            for (int t = 0; t < 64; ++t) {
                const float vv = Vs[t * 128 + 16 * w + v16]; float oo = 0.f;
#pragma unroll
                for (int i = 0; i < 16; ++i) { const int kk = 16 * kq + i; S[i] = Fs[t * 64 + kk] * S[i] + Ks[t * 64 + kk] * vv; oo += Qs[t * 64 + kk] * S[i]; }
                oo += __shfl_xor(oo, 16); oo += __shfl_xor(oo, 32);
                if (kq == 0) Os[t * 128 + 16 * w + v16] = oo;
            }
            __syncthreads();
            for (int rr = 0; rr < 8; ++rr) { const int r = 8 * w + rr; const float oa = Os[r * 128 + 2 * lane], ob = Os[r * 128 + 2 * lane + 1];
                const float rstd = 1.0f / sqrtf(wave_sum(oa * oa + ob * ob) * (1.0f / 128.f) + RMS_EPS);
                const unsigned r2 = *(const unsigned*)(proj + (m0 + r) * NPROJ + PC_GR + h * 128 + 2 * lane); const float ra = bflo(r2), rb = bfhi(r2);
                const float ya = oa * rstd * ng[2 * lane] * (ra / (1.0f + expf(-ra))), yb = ob * rstd * ng[2 * lane + 1] * (rb / (1.0f + expf(-rb)));
                *(unsigned*)(mixed + (m0 + r) * D_MODEL + MC_GLA + h * 128 + 2 * lane) = pk2(ya, yb); }
        }
    }
}
__device__ __forceinline__ void ph_gemm(const Params& P, int l, int s, const Ctx& C) {
    pg8::Gemm g; pg8::EpiAny E;
    if (s == 0)      { g = pg8::Gemm{ws_h(P), ws_wt(P, l, WT_IN), MTOK, NPROJ, D_MODEL};      E = pg8::EpiAny{0, ws_proj(P), nullptr, nullptr, NPROJ}; }
    else if (s == 1) { g = pg8::Gemm{ws_mixed(P), ws_wt(P, l, WT_OUT), MTOK, D_MODEL, D_MODEL}; E = pg8::EpiAny{1, nullptr, l == 0 ? P.x : P.out, P.out, D_MODEL}; }
    else if (s == 2) { g = pg8::Gemm{ws_h(P), ws_wt(P, l, WT_GU), MTOK, NGU, D_MODEL};        E = pg8::EpiAny{2, ws_ff(P), nullptr, nullptr, DFF}; }
    else             { g = pg8::Gemm{ws_ff(P), ws_wt(P, l, WT_DN), MTOK, D_MODEL, DFF};       E = pg8::EpiAny{1, nullptr, P.out, P.out, D_MODEL}; }
    pg8::StaticOrder S; S.init(g.M, g.N, C.G, C.bid);
    pg8::gemm_phase<pg8::EpiAny, pg8::StaticOrder, true, true>(C.lds, g, S, E);
}

#define XB_TMO      128
#define XB_XCNT(j)  (256  + 64 * (j))
#define XB_XSUB(j)  (1280 + 64 * (j))
#define XB_XGEN(j)  (2304 + 64 * (j))
#define XB_TOP      3328
#define XB_TOPGEN   3392
#define XCD_BAR_WORDS 3456
#define XB_SPIN_CAP (1u << 18)

__device__ __forceinline__ unsigned xb_ld(unsigned* p)              { return __hip_atomic_load(p, __ATOMIC_RELAXED, __HIP_MEMORY_SCOPE_AGENT); }
__device__ __forceinline__ unsigned xb_add(unsigned* p, unsigned v) { return __hip_atomic_fetch_add(p, v, __ATOMIC_RELAXED, __HIP_MEMORY_SCOPE_AGENT); }
__device__ __forceinline__ unsigned xb_xcc_id() { return (unsigned)__builtin_amdgcn_s_getreg((3 << 11) | 20) & 0xFu; }
#define XB_SPIN(cond, bar) do { unsigned _sp = 0; while (cond) { __builtin_amdgcn_s_sleep(1); \
    if ((++_sp & 255u) == 0u) { if (xb_ld(&(bar)[XB_TMO])) break; if (_sp > XB_SPIN_CAP) { atomicAdd(&(bar)[XB_TMO], 1u); break; } } } } while (0)

struct XcdBarrier {
    unsigned* bar; unsigned x;
    volatile LAS unsigned* st;
};

__device__ __forceinline__ XcdBarrier xcd_barrier_post(unsigned* bar, volatile LAS unsigned* st) {
    XcdBarrier b; b.bar = bar; b.x = xb_xcc_id(); b.st = st;
    if (threadIdx.x == 0) (void)xb_add(&bar[XB_XCNT(b.x)], 1u);
    return b;
}
__device__ __forceinline__ void xcd_barrier_complete(unsigned* bar, unsigned x, unsigned& nloc, unsigned& nx) {
    const unsigned G = gridDim.x * gridDim.y * gridDim.z;
    unsigned sum, cnt, mine, sp = 0u;
    for (;;) {
        sum = 0u; cnt = 0u; mine = 0u;
#pragma unroll
        for (unsigned j = 0; j < 16; ++j) { const unsigned c = xb_ld(&bar[XB_XCNT(j)]); sum += c; cnt += (c > 0u) ? 1u : 0u; mine = (j == x) ? c : mine; }
        if (sum == G) break;
        __builtin_amdgcn_s_sleep(1);
        if ((++sp & 255u) == 0u) { if (xb_ld(&bar[XB_TMO])) break; if (sp > XB_SPIN_CAP) { atomicAdd(&bar[XB_TMO], 1u); break; } }
    }
    nloc = mine > 0u ? mine : 1u; nx = cnt > 0u ? cnt : 1u;
}

__device__ __forceinline__ void xcd_barrier(const XcdBarrier& b) {
    asm volatile("s_waitcnt vmcnt(0)" ::: "memory");
    __syncthreads();
    if (threadIdx.x == 0) {
        unsigned* bar = b.bar;
        __builtin_amdgcn_s_waitcnt(0);
        unsigned nloc = b.st[0], nx = b.st[1];
        if (nloc == 0u) { xcd_barrier_complete(bar, b.x, nloc, nx); b.st[0] = nloc; b.st[1] = nx; }
        const unsigned old = xb_add(&bar[XB_XSUB(b.x)], 1u);
        const unsigned gen = old / nloc;
        if (old + 1u == (gen + 1u) * nloc) {
            __builtin_amdgcn_fence(__ATOMIC_RELEASE, "agent");
            asm volatile("s_waitcnt vmcnt(0)" ::: "memory");
            const unsigned og = xb_add(&bar[XB_TOP], 1u);
            const unsigned tg = og / nx;
            if (og + 1u == (tg + 1u) * nx) xb_add(&bar[XB_TOPGEN], 1u);
            else XB_SPIN(xb_ld(&bar[XB_TOPGEN]) == tg, bar);
            __builtin_amdgcn_fence(__ATOMIC_ACQUIRE, "agent");
            xb_add(&bar[XB_XGEN(b.x)], 1u);
            asm volatile("s_waitcnt vmcnt(0)" ::: "memory");
        } else {
            XB_SPIN(xb_ld(&bar[XB_XGEN(b.x)]) == gen, bar);
            __builtin_amdgcn_fence(__ATOMIC_ACQUIRE, "agent");
            asm volatile("s_waitcnt vmcnt(0)" ::: "memory");
        }
    }
    __syncthreads();
}


constexpr int LDS_BYTES = 147456;
constexpr int MISC_OFF = LDS_BYTES - 256;
constexpr int CW_BAR = 4096;
__global__ void __launch_bounds__(512, 2) mk_fwd(Params P) {
    extern __shared__ __attribute__((aligned(16))) unsigned char lds[];
    Ctx C; C.lds = (LAS unsigned char*)lds; C.tid = threadIdx.x; C.lane = C.tid & 63; C.wave = __builtin_amdgcn_readfirstlane(C.tid >> 6); C.bid = blockIdx.x; C.G = gridDim.x;
    volatile LAS unsigned* MISC = (volatile LAS unsigned*)(C.lds + MISC_OFF);
    if (C.tid < 64) MISC[C.tid] = 0u;
    __syncthreads();
    XcdBarrier bar = xcd_barrier_post((unsigned*)(P.ws + WS_CTL) + CW_BAR, MISC);
    bar.x = (unsigned)__builtin_amdgcn_readfirstlane((int)bar.x);
#define GRID_BAR() do { XcdBarrier b_ = bar; asm volatile("" : "+s"(b_.x), "+s"(b_.bar)); xcd_barrier(b_); } while (0)

    ph_convert(P, C);
    GRID_BAR();
#define FRESH(Cn) Ctx Cn = C; { int t_ = C.tid; asm volatile("" : "+v"(t_)); Cn.tid = t_; Cn.lane = t_ & 63; }
#pragma unroll 1
    for (int l = 0; l < DEPTH; ++l) {
#pragma unroll 1
        for (int s = 0; s < 4; ++s) {
            if (s == 0) {
                { FRESH(C1); ph_rmsnorm(l == 0 ? P.x : P.out, P.norm1_g + l * D_MODEL, ws_h(P), C1); }
                VM_WAIT(); __syncthreads();
                { FRESH(C1); ph_ga_naive(P, l, C1); }
            } else if (s == 1) {
                { FRESH(C1); ph_gla_naive(P, l, C1); }
                { FRESH(C1); ph_conv(P, l, C1); }
                { FRESH(C1); ph_pool_naive(P, l, C1); }
                { FRESH(C1); ph_sb_naive(P, l, C1); }
            } else if (s == 2) {
                { FRESH(C1); ph_rmsnorm(P.out, P.norm2_g + l * D_MODEL, ws_h(P), C1); }
            }
            if (s != 3) GRID_BAR();
            { FRESH(C1); ph_gemm(P, l, s, C1); }
            if (l + 1 < DEPTH || s != 3) GRID_BAR();
        }
    }
}

extern "C" void kernel_launch(void* const* d_in, const int* in_sizes, int n_in, void* d_out, int out_size, void* d_ws, size_t ws_size, hipStream_t stream) {
    static int grid = 0;
    if (grid == 0) {
        if (n_in != 16 || in_sizes[0] != MTOK * D_MODEL || out_size != MTOK * D_MODEL || ws_size < WS_END) {
            fprintf(stderr, "kernel_launch: unexpected shapes / workspace: n_in %d in0 %d out %d ws %zu (need %zu); nothing launched\n", n_in, n_in > 0 ? in_sizes[0] : -1, out_size, ws_size, (size_t)WS_END); grid = -1; return; }
        int dev = 0, cus = 0, per_cu = 0;
        if (hipGetDevice(&dev) != hipSuccess || hipDeviceGetAttribute(&cus, hipDeviceAttributeMultiprocessorCount, dev) != hipSuccess) { fprintf(stderr, "kernel_launch: device query failed\n"); grid = -1; return; }
        if (hipFuncSetAttribute((const void*)mk_fwd, hipFuncAttributeMaxDynamicSharedMemorySize, LDS_BYTES) != hipSuccess) { fprintf(stderr, "kernel_launch: hipFuncSetAttribute failed\n"); grid = -1; return; }
        if (hipOccupancyMaxActiveBlocksPerMultiprocessor(&per_cu, (const void*)mk_fwd, 512, LDS_BYTES) != hipSuccess || per_cu < 1) { fprintf(stderr, "kernel_launch: occupancy query says %d blocks per CU\n", per_cu); (void)hipGetLastError(); }
        grid = cus;
    }
    if (grid < 0) return;
    if (hipMemsetAsync((char*)d_ws + WS_CTL, 0, 65536, stream) != hipSuccess) { fprintf(stderr, "kernel_launch: memset failed\n"); return; }
    Params P{};
    P.x = (const float*)d_in[0]; P.norm1_g = (const float*)d_in[1]; P.w_in = (const float*)d_in[2]; P.conv_w = (const float*)d_in[3]; P.sb_q_g = (const float*)d_in[4]; P.sb_k_g = (const float*)d_in[5];
    P.gla_a_w = (const float*)d_in[6]; P.gla_a_b = (const float*)d_in[7]; P.gla_norm_g = (const float*)d_in[8]; P.pool_w = (const float*)d_in[9]; P.pool_scale = (const float*)d_in[10];
    P.w_out = (const float*)d_in[11]; P.norm2_g = (const float*)d_in[12]; P.w_gate = (const float*)d_in[13]; P.w_up = (const float*)d_in[14]; P.w_down = (const float*)d_in[15];
    P.out = (float*)d_out; P.ws = (unsigned char*)d_ws;
    hipLaunchKernelGGL(mk_fwd, dim3(grid), dim3(512), LDS_BYTES, stream, P);
    const hipError_t le = hipPeekAtLastError();
    if (le != hipSuccess) fprintf(stderr, "kernel_launch: launch failed: %s\n", hipGetErrorName(le));
}
```

```cpp
#include <hip/hip_runtime.h>
#include <cstdio>
#include <cstdint>

#define LAS __attribute__((address_space(3)))
typedef unsigned short bf16;
typedef float f32x4 __attribute__((ext_vector_type(4)));
typedef float f32x2 __attribute__((ext_vector_type(2)));
typedef unsigned u32x4 __attribute__((ext_vector_type(4)));
typedef unsigned u32x2 __attribute__((ext_vector_type(2)));
typedef short bf16x8 __attribute__((ext_vector_type(8)));

constexpr int D_MODEL = 2048, BATCH = 8, SEQ = 2048, DEPTH = 4, MTOK = BATCH * SEQ;
constexpr int GW = 512, IN_COLS = 5136, NPROJ = 5120, DFF = 5632, NGU = 2 * DFF;
constexpr float RMS_EPS = 1e-6f;
constexpr int PC_CB = 0, PC_CC = 512, PC_CH = 1024, PC_SQ = 1536, PC_SK = 2048, PC_SV = 2560, PC_GQ = 3072, PC_GK = 3328, PC_GV = 3584, PC_GR = 4096, PC_PU = 4608;
constexpr int MC_CONV = 0, MC_SB = 512, MC_GLA = 1024, MC_POOL = 1536;

constexpr size_t MiB = 1u << 20;
constexpr size_t WS_CTL = 0, CTL_BYTES = 1 * MiB;
constexpr size_t WS_WT = 1 * MiB;
constexpr size_t WT_IN = 0, WT_OUT = 21 * MiB, WT_GU = 29 * MiB, WT_DN = 73 * MiB, WT_PW = 95 * MiB, WT_STRIDE = 96 * MiB;
static_assert((size_t)(NPROJ + 16) * D_MODEL * 2 <= WT_OUT && (size_t)NGU * D_MODEL * 2 == 44 * MiB && (size_t)D_MODEL * DFF * 2 == 22 * MiB, "weight map");
constexpr size_t WS_H = WS_WT + DEPTH * WT_STRIDE;
constexpr size_t WS_PROJ = WS_H + 64 * MiB;
constexpr size_t WS_MIXED = WS_PROJ + 176 * MiB;
constexpr size_t WS_GA = WS_MIXED + 64 * MiB;
constexpr size_t WS_SCR = WS_GA + 1 * MiB;
constexpr size_t WS_END = WS_SCR + 112 * MiB;

struct Params {
    const float* x; const float* norm1_g; const float* w_in; const float* conv_w; const float* sb_q_g; const float* sb_k_g;
    const float* gla_a_w; const float* gla_a_b; const float* gla_norm_g; const float* pool_w; const float* pool_scale;
    const float* w_out; const float* norm2_g; const float* w_gate; const float* w_up; const float* w_down;
    float* out; unsigned char* ws;
};

#define LDS_WAIT() asm volatile("s_waitcnt lgkmcnt(0)" ::: "memory")
#define VM_WAIT() asm volatile("s_waitcnt vmcnt(0)" ::: "memory")
__device__ __forceinline__ float bf2f(unsigned b) { return __uint_as_float(b << 16); }
__device__ __forceinline__ float bflo(unsigned w) { return __uint_as_float(w << 16); }
__device__ __forceinline__ float bfhi(unsigned w) { return __uint_as_float(w & 0xffff0000u); }
__device__ __forceinline__ unsigned f2bf(float f) { unsigned u = __float_as_uint(f); return (u + 0x7fffu + ((u >> 16) & 1u)) >> 16; }
__device__ __forceinline__ unsigned pk2(float lo, float hi) { return f2bf(lo) | (f2bf(hi) << 16); }
__device__ __forceinline__ float wave_sum(float v) {
#pragma unroll
    for (int o = 1; o < 64; o <<= 1) v += __shfl_xor(v, o);
    return v;
}
__device__ __forceinline__ float log_sigmoid(float z) { return fminf(z, 0.f) - log1pf(expf(-fabsf(z))); }

struct Ctx { LAS unsigned char* lds; int tid, lane, wave, bid, G; };
namespace pg8 {
#define PG8_LAS __attribute__((address_space(3)))
typedef unsigned short bf16_t;
typedef short bf16x8 __attribute__((ext_vector_type(8)));
typedef float f32x4 __attribute__((ext_vector_type(4)));
typedef unsigned u32x4 __attribute__((ext_vector_type(4)));
constexpr int BM = 256, BK = 64, HALF = 128, HTB = HALF * BK * 2  , STAGE_BYTES = 8 * HTB, NXCD = 8, WGM = 8;

__host__ __device__ __forceinline__ int lds_byte(int r, int c) { const int st = (r >> 4) * 2 + (c >> 5), rr = r & 15, cc = c & 31, ob = rr * 64 + cc * 2; return st * 1024 + (ob ^ (((ob >> 9) & 1) << 5)); }
__host__ __device__ __forceinline__ void stage_rc(int b, int& R, int& C) { const int st = b / 1024, sb = b % 1024, swz = sb ^ (((sb >> 9) & 1) << 5); R = (st >> 1) * 16 + swz / 64; C = (st & 1) * 32 + (swz % 64) / 2; }
__host__ __device__ __forceinline__ int perm32(int rho) { const int n = rho >> 4, i = rho & 15; return 8 * (i >> 2) + 4 * n + (i & 3); }

struct Unit { int pm, pn; };
struct Gemm { const bf16_t* A; const bf16_t* Bt; int M, N, K; };

struct StaticOrder {
    int nM, nN, nwg, G, c;
    __host__ __device__ void init(int M, int N, int G_, int c_) { nM = M / BM; nN = N / BM; nwg = nM * nN; G = G_; c = c_; }
    __host__ __device__ bool next(int i, Unit& u) const {
        const long L = (long)i * G + c; if (L >= nwg) return false;
        int wgid = (int)L; { const int q = nwg / NXCD, r = nwg % NXCD, xcd = wgid % NXCD, off = wgid / NXCD; wgid = (xcd < r ? xcd * (q + 1) : r * (q + 1) + (xcd - r) * q) + off; }
        const int nig = WGM * nN, gid = wgid / nig, fm = gid * WGM, gsz = (nM - fm) < WGM ? (nM - fm) : WGM;
        u.pm = fm + ((wgid % nig) % gsz); u.pn = (wgid % nig) / gsz; return true;
    }
    __device__ __forceinline__ void a_ready(const Unit&) const {}
    __device__ __forceinline__ void done(const Unit&) const {}
};

__device__ __forceinline__ unsigned cvt_pk_bf16(float lo, float hi) { unsigned r; asm volatile("v_cvt_pk_bf16_f32 %0, %1, %2" : "=v"(r) : "v"(lo), "v"(hi)); return r; }

struct EpiStoreBf16 {
    static constexpr bool PERM = true, AFTER_DRAIN = false; __device__ __forceinline__ bool perm() const { return true; }
    bf16_t* O; int ldc;
    __device__ __forceinline__ void operator()(const f32x4 (&acc)[2][2][4][2], const Unit& u, int wr, int wc, int fr, int fq) const {
        const int row0 = u.pm * BM + wr * 64 + fr, col0 = u.pn * BM + wc * 32 + 8 * fq;
#pragma unroll
        for (int ai = 0; ai < 2; ++ai)
#pragma unroll
            for (int m = 0; m < 4; ++m) { bf16_t* rowp = O + (size_t)(row0 + ai * HALF + m * 16) * ldc + col0;
#pragma unroll
                for (int bj = 0; bj < 2; ++bj) { const f32x4 v0 = acc[ai][bj][m][0], v1 = acc[ai][bj][m][1];
                    u32x4 w; w.x = cvt_pk_bf16(v0[0], v0[1]); w.y = cvt_pk_bf16(v0[2], v0[3]); w.z = cvt_pk_bf16(v1[0], v1[1]); w.w = cvt_pk_bf16(v1[2], v1[3]);
                    *(u32x4*)(rowp + bj * HALF) = w; } }
    }
};
struct EpiResidF32 {
    static constexpr bool PERM = false, AFTER_DRAIN = false; __device__ __forceinline__ bool perm() const { return false; }
    const float* base; float* out; int ldc;
    __device__ __forceinline__ void operator()(const f32x4 (&acc)[2][2][4][2], const Unit& u, int wr, int wc, int fr, int fq) const {
        const int row0 = u.pm * BM + wr * 64 + fr, col0 = u.pn * BM + wc * 32 + 4 * fq;
#pragma unroll
        for (int ai = 0; ai < 2; ++ai)
#pragma unroll
            for (int m = 0; m < 4; ++m) { const size_t off = (size_t)(row0 + ai * HALF + m * 16) * ldc + col0;
#pragma unroll
                for (int bj = 0; bj < 2; ++bj)
#pragma unroll
                    for (int n = 0; n < 2; ++n) { const f32x4 bs = *(const f32x4*)(base + off + bj * HALF + n * 16); *(f32x4*)(out + off + bj * HALF + n * 16) = bs + acc[ai][bj][m][n]; }
                asm volatile("" ::: "memory"); }
    }
};
__device__ __forceinline__ float silu_mul(float g, float u) { return g * u * __builtin_amdgcn_rcpf(1.0f + __builtin_amdgcn_exp2f(-1.4426950408889634f * g)); }
struct EpiSwiGLU {
    static constexpr bool PERM = true, AFTER_DRAIN = false; __device__ __forceinline__ bool perm() const { return true; }
    bf16_t* O; int ldc;
    __device__ __forceinline__ void operator()(const f32x4 (&acc)[2][2][4][2], const Unit& u, int wr, int wc, int fr, int fq) const {
        const int row0 = u.pm * BM + wr * 64 + fr, col0 = u.pn * HALF + wc * 32 + 8 * fq;
#pragma unroll
        for (int ai = 0; ai < 2; ++ai)
#pragma unroll
            for (int m = 0; m < 4; ++m) { bf16_t* rowp = O + (size_t)(row0 + ai * HALF + m * 16) * ldc + col0;
                const f32x4 g0 = acc[ai][0][m][0], g1 = acc[ai][0][m][1], u0 = acc[ai][1][m][0], u1 = acc[ai][1][m][1];
                u32x4 w; w.x = cvt_pk_bf16(silu_mul(g0[0], u0[0]), silu_mul(g0[1], u0[1])); w.y = cvt_pk_bf16(silu_mul(g0[2], u0[2]), silu_mul(g0[3], u0[3]));
                w.z = cvt_pk_bf16(silu_mul(g1[0], u1[0]), silu_mul(g1[1], u1[1])); w.w = cvt_pk_bf16(silu_mul(g1[2], u1[2]), silu_mul(g1[3], u1[3]));
                *(u32x4*)rowp = w; }
    }
};
struct EpiAny {
    static constexpr bool AFTER_DRAIN = false;
    int mode; bf16_t* O; const float* base; float* out; int ldc;
    __device__ __forceinline__ bool perm() const { return mode != 1; }
    __device__ __forceinline__ void operator()(const f32x4 (&acc)[2][2][4][2], const Unit& u, int wr, int wc, int fr, int fq) const {
        if (mode == 0) { EpiStoreBf16 e{O, ldc}; e(acc, u, wr, wc, fr, fq); }
        else if (mode == 1) { EpiResidF32 e{base, out, ldc}; e(acc, u, wr, wc, fr, fq); }
        else { EpiSwiGLU e{O, ldc}; e(acc, u, wr, wc, fr, fq); }
    }
};
template <class Epi, class Sched, bool ALIGN_EPI = false, bool SP2 = false>
__device__ __forceinline__ void gemm_phase(PG8_LAS unsigned char* lds, const Gemm g, const Sched& S, const Epi& E) {
    const int tid = threadIdx.x, wid = __builtin_amdgcn_readfirstlane(tid >> 6), lane = tid & 63, wr = wid >> 2, wc = wid & 3, fr = lane & 15, fq = lane >> 4;
    const int K = g.K, nt = K / BK;
    unsigned voffA[2], voffB[2];
#pragma unroll
    for (int i = 0; i < 2; ++i) { int R, C; stage_rc(tid * 16 + i * 8192, R, C); const int Rb = E.perm() ? ((R & ~31) + perm32(R & 31)) : R;
        voffA[i] = (unsigned)(R * K + C) * 2u; voffB[i] = (unsigned)(Rb * K + C) * 2u; }
    const size_t kstep = (size_t)(BK * 2);
    const size_t hstep = (size_t)HALF * K * 2;
    const size_t tstep = 2 * hstep;
    const unsigned ldsw = (unsigned)wid * 1024u;
    const int aoff = lds_byte(wr * 64 + fr, fq * 8), boff = lds_byte(wc * 32 + fr, fq * 8);
#define PG8_SA(b, h) (((b) * 2 + (h)) * HTB)
#define PG8_SB(b, h) ((4 + (b) * 2 + (h)) * HTB)
#define PG8_STAGE(bufoff, gbase, voff) do { _Pragma("unroll") for (int _i = 0; _i < 2; ++_i) \
        __builtin_amdgcn_global_load_lds((const unsigned*)((const char*)(gbase) + (voff)[_i]), (PG8_LAS unsigned*)(lds + (bufoff) + ldsw + _i * 8192), 16, 0, 0); } while (0)
#define PG8_LDA(dst, b, h) do { _Pragma("unroll") for (int m = 0; m < 4; ++m) _Pragma("unroll") for (int k = 0; k < 2; ++k) dst[m][k] = *(const PG8_LAS bf16x8*)(lds + PG8_SA(b, h) + aoff + m * 2048 + k * 1024); } while (0)
#define PG8_LDB(dst, b, h) do { _Pragma("unroll") for (int n = 0; n < 2; ++n) _Pragma("unroll") for (int k = 0; k < 2; ++k) dst[n][k] = *(const PG8_LAS bf16x8*)(lds + PG8_SB(b, h) + boff + n * 2048 + k * 1024); } while (0)
#define PG8_MMA(ai, bj, At, Bt) do { __builtin_amdgcn_s_setprio(1); _Pragma("unroll") for (int m = 0; m < 4; ++m) _Pragma("unroll") for (int n = 0; n < 2; ++n) _Pragma("unroll") for (int k = 0; k < 2; ++k) \
        acc[ai][bj][m][n] = __builtin_amdgcn_mfma_f32_16x16x32_bf16(Bt[n][k], At[m][k], acc[ai][bj][m][n], 0, 0, 0); __builtin_amdgcn_s_setprio(0); } while (0)
#define PG8_WAIT_V(n) asm volatile("s_waitcnt vmcnt(" #n ")" ::: "memory")
#define PG8_WAIT_L(n) asm volatile("s_waitcnt lgkmcnt(" #n ")" ::: "memory")
#define PG8_BAR __builtin_amdgcn_s_barrier()
#define PG8_SCHED __builtin_amdgcn_sched_barrier(0)
    Unit cur, nxt; int ui = 0;
    if (!S.next(0, cur)) return;
    f32x4 acc[2][2][4][2];
#pragma unroll
    for (int a = 0; a < 2; ++a)
#pragma unroll
        for (int b = 0; b < 2; ++b)
#pragma unroll
            for (int m = 0; m < 4; ++m)
#pragma unroll
                for (int n = 0; n < 2; ++n) acc[a][b][m][n] = (f32x4){0.f, 0.f, 0.f, 0.f};
    bf16x8 At[4][2], B0[2][2], B1[2][2];
    const char* cA = (const char*)g.A + (size_t)cur.pm * tstep; const char* cB = (const char*)g.Bt + (size_t)cur.pn * tstep;
    S.a_ready(cur);
    if constexpr (SP2) {
        PG8_STAGE(PG8_SB(0, 0), cB, voffB); PG8_STAGE(PG8_SB(0, 1), cB + hstep, voffB); PG8_STAGE(PG8_SA(0, 0), cA, voffA); PG8_STAGE(PG8_SA(0, 1), cA + hstep, voffA);
        if (wr == 1) PG8_BAR;
        PG8_WAIT_V(2); PG8_BAR;
        PG8_STAGE(PG8_SB(1, 0), cB + kstep, voffB); PG8_STAGE(PG8_SA(1, 0), cA + kstep, voffA); PG8_STAGE(PG8_SB(1, 1), cB + hstep + kstep, voffB);
        PG8_WAIT_V(6); PG8_BAR;
    } else {
        PG8_STAGE(PG8_SB(0, 0), cB, voffB); PG8_STAGE(PG8_SA(0, 0), cA, voffA); PG8_STAGE(PG8_SB(0, 1), cB + hstep, voffB); PG8_STAGE(PG8_SA(0, 1), cA + hstep, voffA);
        if (wr == 1) PG8_BAR;
        PG8_WAIT_V(4); PG8_BAR;
        PG8_STAGE(PG8_SB(1, 0), cB + kstep, voffB); PG8_STAGE(PG8_SA(1, 0), cA + kstep, voffA); PG8_STAGE(PG8_SB(1, 1), cB + hstep + kstep, voffB);
        PG8_WAIT_V(6); PG8_BAR;
    }
    for (;;) {
        const bool has_next = S.next(ui + 1, nxt);
        const char* nA = has_next ? (const char*)g.A + (size_t)nxt.pm * tstep : cA; const char* nB = has_next ? (const char*)g.Bt + (size_t)nxt.pn * tstep : cB;
        for (int t = 0; t < nt; t += 2) {
            const bool last = (t == nt - 2);
            const char* a1 = cA + (size_t)(t + 1) * kstep;
            const char* a2 = last ? nA : cA + (size_t)(t + 2) * kstep; const char* b2 = last ? nB : cB + (size_t)(t + 2) * kstep;
            const char* a3 = a2 + kstep; const char* b3 = b2 + kstep;
            if (last && has_next) S.a_ready(nxt);
            if constexpr (SP2) {
            PG8_LDB(B0, 0, 0); PG8_LDB(B1, 0, 1); PG8_SCHED; PG8_LDA(At, 0, 0); PG8_STAGE(PG8_SA(1, 1), a1 + hstep, voffA);
            PG8_WAIT_V(8); PG8_WAIT_L(0); PG8_BAR; PG8_MMA(0, 0, At, B0); PG8_MMA(0, 1, At, B1); PG8_BAR; PG8_SCHED;
            PG8_LDA(At, 0, 1); PG8_STAGE(PG8_SB(0, 0), b2, voffB); PG8_STAGE(PG8_SB(0, 1), b2 + hstep, voffB); PG8_STAGE(PG8_SA(0, 0), a2, voffA);
            PG8_WAIT_V(8); PG8_WAIT_L(0); PG8_BAR; PG8_MMA(1, 0, At, B0); PG8_MMA(1, 1, At, B1); PG8_BAR; PG8_SCHED;
            PG8_LDB(B0, 1, 0); PG8_LDB(B1, 1, 1); PG8_SCHED; PG8_LDA(At, 1, 0); PG8_STAGE(PG8_SA(0, 1), a2 + hstep, voffA);
            PG8_WAIT_V(8); PG8_WAIT_L(0); PG8_BAR; PG8_MMA(0, 0, At, B0); PG8_MMA(0, 1, At, B1); PG8_BAR; PG8_SCHED;
            PG8_LDA(At, 1, 1); PG8_STAGE(PG8_SB(1, 0), b3, voffB); PG8_STAGE(PG8_SB(1, 1), b3 + hstep, voffB); PG8_STAGE(PG8_SA(1, 0), a3, voffA);
            PG8_WAIT_V(8); PG8_WAIT_L(0); PG8_BAR; PG8_MMA(1, 0, At, B0); PG8_MMA(1, 1, At, B1); PG8_BAR; PG8_SCHED;
            } else {
            PG8_LDB(B0, 0, 0); PG8_SCHED; PG8_LDA(At, 0, 0); PG8_STAGE(PG8_SA(1, 1), a1 + hstep, voffA);
            PG8_WAIT_L(8); PG8_BAR; PG8_WAIT_L(0); PG8_MMA(0, 0, At, B0); PG8_BAR; PG8_SCHED;
            PG8_LDB(B1, 0, 1); PG8_STAGE(PG8_SB(0, 0), b2, voffB);
            PG8_BAR; PG8_WAIT_L(0); PG8_MMA(0, 1, At, B1); PG8_BAR;
            PG8_LDA(At, 0, 1); PG8_STAGE(PG8_SA(0, 0), a2, voffA);
            PG8_BAR; PG8_WAIT_L(0); PG8_MMA(1, 0, At, B0); PG8_BAR; PG8_SCHED;
            PG8_STAGE(PG8_SB(0, 1), b2 + hstep, voffB);
            PG8_WAIT_V(6); PG8_BAR; PG8_MMA(1, 1, At, B1); PG8_BAR;
            PG8_LDB(B0, 1, 0); PG8_SCHED; PG8_LDA(At, 1, 0); PG8_STAGE(PG8_SA(0, 1), a2 + hstep, voffA);
            PG8_WAIT_L(8); PG8_BAR; PG8_WAIT_L(0); PG8_MMA(0, 0, At, B0); PG8_BAR; PG8_SCHED;
            PG8_LDB(B1, 1, 1); PG8_STAGE(PG8_SB(1, 0), b3, voffB);
            PG8_BAR; PG8_WAIT_L(0); PG8_MMA(0, 1, At, B1); PG8_BAR;
            PG8_LDA(At, 1, 1); PG8_STAGE(PG8_SA(1, 0), a3, voffA);
            PG8_BAR; PG8_WAIT_L(0); PG8_MMA(1, 0, At, B0); PG8_BAR; PG8_SCHED;
            PG8_STAGE(PG8_SB(1, 1), b3 + hstep, voffB);
            PG8_WAIT_V(6); PG8_BAR; PG8_MMA(1, 1, At, B1); PG8_BAR;
            }
        }
        if constexpr (ALIGN_EPI) { if (wr == 0) PG8_BAR; }
        if constexpr (!Epi::AFTER_DRAIN) { E(acc, cur, wr, wc, fr, fq); S.done(cur); }
        if (!has_next) break;
#pragma unroll
        for (int a = 0; a < 2; ++a)
#pragma unroll
            for (int b = 0; b < 2; ++b)
#pragma unroll
                for (int m = 0; m < 4; ++m)
#pragma unroll
                    for (int n = 0; n < 2; ++n) acc[a][b][m][n] = (f32x4){0.f, 0.f, 0.f, 0.f};
        cur = nxt; cA = nA; cB = nB; ++ui;
        if constexpr (ALIGN_EPI) { if (wr == 1) PG8_BAR; }
    }
    PG8_WAIT_V(0);
    if constexpr (!ALIGN_EPI) { if (wr == 0) PG8_BAR; }
    PG8_BAR;
    if constexpr (Epi::AFTER_DRAIN) { E.fused(acc, cur, wr, wc, fr, fq, lds, wid, lane); S.done(cur); }
#undef PG8_SA
#undef PG8_SB
#undef PG8_STAGE
#undef PG8_LDA
#undef PG8_LDB
#undef PG8_MMA
#undef PG8_WAIT_V
#undef PG8_WAIT_L
#undef PG8_BAR
#undef PG8_SCHED
}
}
__device__ __forceinline__ bf16* ws_wt(const Params& P, int l, size_t off) { return (bf16*)(P.ws + WS_WT + (size_t)l * WT_STRIDE + off); }
__device__ __forceinline__ bf16* ws_h(const Params& P) { return (bf16*)(P.ws + WS_H); }
__device__ __forceinline__ bf16* ws_proj(const Params& P) { return (bf16*)(P.ws + WS_PROJ); }
__device__ __forceinline__ bf16* ws_ff(const Params& P) { return (bf16*)(P.ws + WS_PROJ); }
__device__ __forceinline__ bf16* ws_mixed(const Params& P) { return (bf16*)(P.ws + WS_MIXED); }
__device__ __forceinline__ float* ws_ga(const Params& P) { return (float*)(P.ws + WS_GA); }

__device__ __forceinline__ void transpose_item(const float* W, int ldw, int col0, int ncols, bf16* WT, int ldt, int drow0, int k0, LAS float* scr, int lane) {
#pragma unroll 8
    for (int i = 0; i < 32; ++i) { const int kk = 2 * i + (lane >> 5), c = lane & 31; scr[kk * 33 + c] = (c < ncols) ? W[(size_t)(k0 + kk) * ldw + col0 + c] : 0.f; }
    LDS_WAIT();
    const int c8 = lane & 7;
#pragma unroll
    for (int j = 0; j < 4; ++j) { const int n = (lane >> 3) + 8 * j; const LAS float* s = scr + (8 * c8) * 33 + n;
        u32x4 o; o.x = pk2(s[0 * 33], s[1 * 33]); o.y = pk2(s[2 * 33], s[3 * 33]); o.z = pk2(s[4 * 33], s[5 * 33]); o.w = pk2(s[6 * 33], s[7 * 33]);
        if (n < ncols) *(u32x4*)(WT + (size_t)(drow0 + n) * ldt + k0 + 8 * c8) = o; }
    LDS_WAIT();
}
constexpr int CV_IN = 161 * 32, CV_OUT = 64 * 32, CV_GU = 176 * 32, CV_DN = 64 * 88, CV_PW = 32, CV_LAYER = CV_IN + CV_OUT + 3 * CV_GU + CV_PW;
static_assert(CV_GU == CV_DN, "gate/up/down item counts");
__device__ __forceinline__ void ph_convert(const Params& P, const Ctx& C) {
    LAS float* scr = (LAS float*)(C.lds + C.wave * 8704);
    const int gw = C.bid * 8 + C.wave, NGW = C.G * 8;
    for (int it = gw; it < DEPTH * CV_LAYER; it += NGW) {
        const int l = it / CV_LAYER; int r = it % CV_LAYER;
        if (r < CV_IN) { const int nb = r % 161, kb = r / 161; int col0, drow0, nc = 32;
            if (nb < 144) { col0 = 32 * nb; drow0 = 32 * nb; } else if (nb < 160) { col0 = 4624 + 32 * (nb - 144); drow0 = 4608 + 32 * (nb - 144); } else { col0 = 4608; drow0 = NPROJ; nc = 16; }
            transpose_item(P.w_in + (size_t)l * D_MODEL * IN_COLS, IN_COLS, col0, nc, ws_wt(P, l, WT_IN), D_MODEL, drow0, 64 * kb, scr, C.lane); continue; }
        r -= CV_IN;
        if (r < CV_OUT) { const int nb = r % 64, kb = r / 64;
            transpose_item(P.w_out + (size_t)l * D_MODEL * D_MODEL, D_MODEL, 32 * nb, 32, ws_wt(P, l, WT_OUT), D_MODEL, 32 * nb, 64 * kb, scr, C.lane); continue; }
        r -= CV_OUT;
        if (r < 2 * CV_GU) { const int up = r >= CV_GU; if (up) r -= CV_GU; const int nb = r % 176, kb = r / 176;
            transpose_item((up ? P.w_up : P.w_gate) + (size_t)l * D_MODEL * DFF, DFF, 32 * nb, 32, ws_wt(P, l, WT_GU), D_MODEL, 256 * (nb >> 2) + 32 * (nb & 3) + (up ? 128 : 0), 64 * kb, scr, C.lane); continue; }
        r -= 2 * CV_GU;
        if (r < CV_DN) { const int nb = r % 64, kb = r / 64;
            transpose_item(P.w_down + (size_t)l * DFF * D_MODEL, D_MODEL, 32 * nb, 32, ws_wt(P, l, WT_DN), DFF, 32 * nb, 64 * kb, scr, C.lane); continue; }
        r -= CV_DN;
        { const int g = r >> 3, nb = r & 3, kb = (r >> 2) & 1;
            transpose_item(P.pool_w + (size_t)(l * 4 + g) * 128 * 128, 128, 32 * nb, 32, ws_wt(P, l, WT_PW) + (size_t)g * 128 * 128, 128, 32 * nb, 64 * kb, scr, C.lane); }
    }
}

__device__ __forceinline__ void ph_rmsnorm(const float* x, const float* g, bf16* h, const Ctx& C) {
    const int gw = C.bid * 8 + C.wave, NGW = C.G * 8;
    for (int m = gw; m < MTOK; m += NGW) {
        const f32x4* xr = (const f32x4*)(x + (size_t)m * D_MODEL) + C.lane;
        f32x4 v[8]; float s = 0.f;
#pragma unroll
        for (int j = 0; j < 8; ++j) { v[j] = xr[64 * j]; s += (v[j].x * v[j].x + v[j].y * v[j].y) + (v[j].z * v[j].z + v[j].w * v[j].w); }
        const float rstd = 1.0f / sqrtf(wave_sum(s) * (1.0f / D_MODEL) + RMS_EPS);
        u32x2* o8 = (u32x2*)(h + (size_t)m * D_MODEL) + C.lane;
#pragma unroll
        for (int j = 0; j < 8; ++j) { const f32x4 gg = ((const f32x4*)g)[C.lane + 64 * j];
            u32x2 w; w.x = pk2(v[j].x * rstd * gg.x, v[j].y * rstd * gg.y); w.y = pk2(v[j].z * rstd * gg.z, v[j].w * rstd * gg.w); o8[64 * j] = w; }
    }
}

__device__ __forceinline__ float dot8_bf16(const u32x4 a, const u32x4 b) {
    return bflo(a.x) * bflo(b.x) + bfhi(a.x) * bfhi(b.x) + bflo(a.y) * bflo(b.y) + bfhi(a.y) * bfhi(b.y) + bflo(a.z) * bflo(b.z) + bfhi(a.z) * bfhi(b.z) + bflo(a.w) * bflo(b.w) + bfhi(a.w) * bfhi(b.w);
}
__device__ __forceinline__ void ph_ga_naive(const Params& P, int l, const Ctx& C) {
    const bf16* h = ws_h(P); const bf16* wa = ws_wt(P, l, WT_IN) + (size_t)NPROJ * D_MODEL; float* ga = ws_ga(P);
    const int gw = C.bid * 8 + C.wave, NGW = C.G * 8;
    for (int m = gw; m < MTOK; m += NGW) {
        float acc[16];
#pragma unroll
        for (int j = 0; j < 16; ++j) acc[j] = 0.f;
#pragma unroll 1
        for (int i = 0; i < 4; ++i) {
            const u32x4 hv = *(const u32x4*)(h + (size_t)m * D_MODEL + 8 * C.lane + 512 * i);
#pragma unroll
            for (int j = 0; j < 16; ++j) { const u32x4 wv = *(const u32x4*)(wa + (size_t)j * D_MODEL + 8 * C.lane + 512 * i); acc[j] += dot8_bf16(hv, wv); }
        }
        float val = 0.f;
#pragma unroll
        for (int j = 0; j < 16; ++j) { const float s = wave_sum(acc[j]); val = (C.lane == j) ? s : val; }
        if (C.lane < 16) ga[(size_t)m * 16 + C.lane] = val;
    }
}

__device__ __forceinline__ void ph_conv(const Params& P, int l, const Ctx& C) {
    const bf16* proj = ws_proj(P); bf16* mixed = ws_mixed(P); const float* cw = P.conv_w + (size_t)l * 3 * GW;
    for (int it = C.bid * 512 + C.tid; it < MTOK * 64; it += C.G * 512) {
        const int m = it >> 6, c8 = (it & 63) * 8, t = m & (SEQ - 1);
        float acc[8];
#pragma unroll
        for (int e = 0; e < 8; ++e) acc[e] = 0.f;
#pragma unroll
        for (int i = 0; i < 3; ++i) { if (t - 2 + i >= 0) {
            const u32x4 cc = *(const u32x4*)(proj + (size_t)(m - 2 + i) * NPROJ + PC_CC + c8), hh = *(const u32x4*)(proj + (size_t)(m - 2 + i) * NPROJ + PC_CH + c8);
            const f32x4 w0 = *(const f32x4*)(cw + i * GW + c8), w1 = *(const f32x4*)(cw + i * GW + c8 + 4);
            acc[0] += w0.x * bflo(cc.x) * bflo(hh.x); acc[1] += w0.y * bfhi(cc.x) * bfhi(hh.x); acc[2] += w0.z * bflo(cc.y) * bflo(hh.y); acc[3] += w0.w * bfhi(cc.y) * bfhi(hh.y);
            acc[4] += w1.x * bflo(cc.z) * bflo(hh.z); acc[5] += w1.y * bfhi(cc.z) * bfhi(hh.z); acc[6] += w1.z * bflo(cc.w) * bflo(hh.w); acc[7] += w1.w * bfhi(cc.w) * bfhi(hh.w); } }
        const u32x4 bb = *(const u32x4*)(proj + (size_t)m * NPROJ + PC_CB + c8);
        u32x4 o; o.x = pk2(bflo(bb.x) * acc[0], bfhi(bb.x) * acc[1]); o.y = pk2(bflo(bb.y) * acc[2], bfhi(bb.y) * acc[3]); o.z = pk2(bflo(bb.z) * acc[4], bfhi(bb.z) * acc[5]); o.w = pk2(bflo(bb.w) * acc[6], bfhi(bb.w) * acc[7]);
        *(u32x4*)(mixed + (size_t)m * D_MODEL + MC_CONV + c8) = o;
    }
}

__device__ __forceinline__ void ph_pool_naive(const Params& P, int l, const Ctx& C) {
    const bf16* proj = ws_proj(P); bf16* mixed = ws_mixed(P);
    LAS float* Ps = (LAS float*)C.lds;
    for (int unit = C.bid; unit < 256 * 4; unit += C.G) {
        const int g = unit & 3, m0 = (unit >> 2) * 64, w = 2 << g;
        __syncthreads();
        { const int c = C.tid & 127, tq = C.tid >> 7;
          for (int tk = 0; tk < 16; ++tk) { const int m = m0 + 16 * tq + tk, t = m & (SEQ - 1), cnt = (t + 1 < w) ? t + 1 : w; float s = 0.f;
              for (int i = 0; i < cnt; ++i) s += bf2f(proj[(size_t)(m - i) * NPROJ + PC_PU + g * 128 + c]);
              Ps[(16 * tq + tk) * 128 + c] = s / (float)cnt - bf2f(proj[(size_t)m * NPROJ + PC_PU + g * 128 + c]); } }
        __syncthreads();
        { const int d = C.tid & 127, tq = C.tid >> 7; const float* pw = P.pool_w + (size_t)(l * 4 + g) * 128 * 128; float acc[16];
#pragma unroll
          for (int tk = 0; tk < 16; ++tk) acc[tk] = 0.f;
          for (int c = 0; c < 128; ++c) { const float wv = pw[c * 128 + d];
#pragma unroll
              for (int tk = 0; tk < 16; ++tk) acc[tk] += Ps[(16 * tq + tk) * 128 + c] * wv; }
          const float sc = P.pool_scale[l * GW + g * 128 + d];
#pragma unroll
          for (int tk = 0; tk < 16; ++tk) mixed[(size_t)(m0 + 16 * tq + tk) * D_MODEL + MC_POOL + g * 128 + d] = (bf16)f2bf(acc[tk] * sc); }
    }
}

__device__ __forceinline__ void ph_sb_naive(const Params& P, int l, const Ctx& C) {
    const bf16* proj = ws_proj(P); bf16* mixed = ws_mixed(P);
    LAS float* Ks = (LAS float*)C.lds;
    LAS float* Vs = Ks + 64 * 129;
    LAS float* Qs = Vs + 64 * 128;
    const float* qg = P.sb_q_g + l * 128; const float* kg = P.sb_k_g + l * 128;
    const int w = C.wave, lane = C.lane;
    for (int unit = C.bid; unit < 32 * 256; unit += C.G) {
        const int bh = unit >> 8, tg = unit & 255, b = bh >> 2, h = bh & 3, t0 = 8 * tg; const size_t mrow0 = (size_t)b * SEQ;
        __syncthreads();
        { const unsigned q2 = *(const unsigned*)(proj + (mrow0 + t0 + w) * NPROJ + PC_SQ + h * 128 + 2 * lane); const float qa = bflo(q2), qb = bfhi(q2);
          const float r = 1.0f / sqrtf(wave_sum(qa * qa + qb * qb) * (1.0f / 128.f) + RMS_EPS) * 0.08838834764831845f;
          Qs[w * 128 + 2 * lane] = qa * r * qg[2 * lane]; Qs[w * 128 + 2 * lane + 1] = qb * r * qg[2 * lane + 1]; }
        const int t = t0 + w; float carry = 0.f, o0 = 0.f, o1 = 0.f;
        const int nkb = (t0 + 6) / 64 + 1;
        for (int kb = nkb - 1; kb >= 0; --kb) {
            __syncthreads();
            for (int rr = 0; rr < 8; ++rr) { const int r = 8 * w + rr; const size_t mrow = mrow0 + kb * 64 + r;
                const unsigned k2 = *(const unsigned*)(proj + mrow * NPROJ + PC_SK + h * 128 + 2 * lane), v2 = *(const unsigned*)(proj + mrow * NPROJ + PC_SV + h * 128 + 2 * lane);
                const float ka = bflo(k2), kb2 = bfhi(k2); const float rs = 1.0f / sqrtf(wave_sum(ka * ka + kb2 * kb2) * (1.0f / 128.f) + RMS_EPS);
                Ks[r * 129 + 2 * lane] = ka * rs * kg[2 * lane]; Ks[r * 129 + 2 * lane + 1] = kb2 * rs * kg[2 * lane + 1];
                Vs[r * 128 + 2 * lane] = bflo(v2); Vs[r * 128 + 2 * lane + 1] = bfhi(v2); }
            __syncthreads();
            const int s = kb * 64 + lane; const bool valid = s < t;
            float z = 0.f;
#pragma unroll 8
            for (int d = 0; d < 128; ++d) z += Qs[w * 128 + d] * Ks[lane * 129 + d];
            const float ls = log_sigmoid(z), lr = valid ? ls - z : 0.f;
            float incl = lr;
#pragma unroll
            for (int o = 1; o < 64; o <<= 1) { const float tmp = __shfl_down(incl, o); if (lane + o < 64) incl += tmp; }
            const float sfx = incl - lr, total = __shfl(incl, 0);
            const float a = valid ? expf(ls + sfx + carry) : 0.f;
            carry += total;
#pragma unroll 8
            for (int j = 0; j < 64; ++j) { const float aj = __shfl(a, j); o0 += aj * Vs[j * 128 + lane]; o1 += aj * Vs[j * 128 + lane + 64]; }
        }
        bf16* orow = mixed + (mrow0 + t) * D_MODEL + MC_SB + h * 128;
        orow[lane] = (bf16)f2bf(o0); orow[lane + 64] = (bf16)f2bf(o1);
    }
}

__device__ __forceinline__ void ph_gla_naive(const Params& P, int l, const Ctx& C) {
    const bf16* proj = ws_proj(P); bf16* mixed = ws_mixed(P); const float* ga = ws_ga(P);
    LAS float* Qs = (LAS float*)C.lds;
    LAS float* Ks = Qs + 4096;
    LAS float* Fs = Ks + 4096;
    LAS float* Vs = Fs + 4096;
    LAS float* Os = Vs + 8192;
    LAS float* Gs = Os + 8192;
    LAS float* AW = Gs + 1024;
    LAS float* AB = AW + 1024;
    const int tid = C.tid, lane = C.lane, w = C.wave, kq = lane >> 4, v16 = lane & 15;
    const float* ng = P.gla_norm_g + l * 128;
    for (int unit = C.bid; unit < 32; unit += C.G) {
        const int b = unit >> 2, h = unit & 3;
        __syncthreads();
        for (int i = tid; i < 1024; i += 512) AW[i] = P.gla_a_w[(size_t)l * 16 * 256 + (i >> 6) * 256 + h * 64 + (i & 63)];
        if (tid < 64) AB[tid] = P.gla_a_b[l * 256 + h * 64 + tid];
        float S[16];
#pragma unroll
        for (int i = 0; i < 16; ++i) S[i] = 0.f;
        for (int c = 0; c < 32; ++c) {
            const size_t m0 = (size_t)b * SEQ + 64 * c;
            __syncthreads();
            { const int row = tid >> 3, c8 = (tid & 7) * 8;
              const u32x4 q4 = *(const u32x4*)(proj + (m0 + row) * NPROJ + PC_GQ + h * 64 + c8), k4 = *(const u32x4*)(proj + (m0 + row) * NPROJ + PC_GK + h * 64 + c8);
              LAS float* qd = Qs + row * 64 + c8; LAS float* kd = Ks + row * 64 + c8;
              qd[0] = bflo(q4.x) * 0.125f; qd[1] = bfhi(q4.x) * 0.125f; qd[2] = bflo(q4.y) * 0.125f; qd[3] = bfhi(q4.y) * 0.125f; qd[4] = bflo(q4.z) * 0.125f; qd[5] = bfhi(q4.z) * 0.125f; qd[6] = bflo(q4.w) * 0.125f; qd[7] = bfhi(q4.w) * 0.125f;
              kd[0] = bflo(k4.x); kd[1] = bfhi(k4.x); kd[2] = bflo(k4.y); kd[3] = bfhi(k4.y); kd[4] = bflo(k4.z); kd[5] = bfhi(k4.z); kd[6] = bflo(k4.w); kd[7] = bfhi(k4.w);
              const int c16 = (tid & 7) * 16;
#pragma unroll
              for (int hh = 0; hh < 2; ++hh) { const u32x4 v4 = *(const u32x4*)(proj + (m0 + row) * NPROJ + PC_GV + h * 128 + c16 + 8 * hh); LAS float* vd = Vs + row * 128 + c16 + 8 * hh;
                  vd[0] = bflo(v4.x); vd[1] = bfhi(v4.x); vd[2] = bflo(v4.y); vd[3] = bfhi(v4.y); vd[4] = bflo(v4.z); vd[5] = bfhi(v4.z); vd[6] = bflo(v4.w); vd[7] = bfhi(v4.w); }
              if (tid < 256) { const f32x4 g4 = *(const f32x4*)(ga + (m0 + (tid >> 2)) * 16 + (tid & 3) * 4); LAS float* gd = Gs + (tid >> 2) * 16 + (tid & 3) * 4; gd[0] = g4.x; gd[1] = g4.y; gd[2] = g4.z; gd[3] = g4.w; } }
            __syncthreads();
            { const int row = tid >> 3, k8 = (tid & 7) * 8;
#pragma unroll
              for (int e = 0; e < 8; ++e) { const int k = k8 + e; float lg = AB[k];
#pragma unroll
                  for (int j = 0; j < 16; ++j) lg += Gs[row * 16 + j] * AW[j * 64 + k];
                  Fs[row * 64 + k] = expf(log_sigmoid(lg) * (1.0f / 16.0f)); } }
            __syncthreads();
            for (int t = 0; t < 64; ++t) {
                const float vv = Vs[t * 128 + 16 * w + v16]; float oo = 0.f;
#pragma unroll
                for (int i = 0; i < 16; ++i) { const int kk = 16 * kq + i; S[i] = Fs[t * 64 + kk] * S[i] + Ks[t * 64 + kk] * vv; oo += Qs[t * 64 + kk] * S[i]; }
                oo += __shfl_xor(oo, 16); oo += __shfl_xor(oo, 32);
                if (kq == 0) Os[t * 128 + 16 * w + v16] = oo;
            }
            __syncthreads();
            for (int rr = 0; rr < 8; ++rr) { const int r = 8 * w + rr; const float oa = Os[r * 128 + 2 * lane], ob = Os[r * 128 + 2 * lane + 1];
                const float rstd = 1.0f / sqrtf(wave_sum(oa * oa + ob * ob) * (1.0f / 128.f) + RMS_EPS);
                const unsigned r2 = *(const unsigned*)(proj + (m0 + r) * NPROJ + PC_GR + h * 128 + 2 * lane); const float ra = bflo(r2), rb = bfhi(r2);
                const float ya = oa * rstd * ng[2 * lane] * (ra / (1.0f + expf(-ra))), yb = ob * rstd * ng[2 * lane + 1] * (rb / (1.0f + expf(-rb)));
                *(unsigned*)(mixed + (m0 + r) * D_MODEL + MC_GLA + h * 128 + 2 * lane) = pk2(ya, yb); }
        }
    }
}
typedef float f32x16 __attribute__((ext_vector_type(16)));
typedef short s16x4 __attribute__((ext_vector_type(4)));
typedef short v4i16_t __attribute__((ext_vector_type(4)));
#define MFMA16(a, b, c) __builtin_amdgcn_mfma_f32_16x16x32_bf16((a), (b), (c), 0, 0, 0)
#define MFMA32(a, b, c) __builtin_amdgcn_mfma_f32_32x32x16_bf16((a), (b), (c), 0, 0, 0)
__device__ __forceinline__ s16x4 lds_tr(const LAS unsigned char* p) { return __builtin_bit_cast(s16x4, __builtin_amdgcn_ds_read_tr16_b64_v4i16((LAS v4i16_t*)p)); }
__device__ __forceinline__ bf16x8 cat8(s16x4 lo, s16x4 hi) { return __builtin_shufflevector(lo, hi, 0, 1, 2, 3, 4, 5, 6, 7); }
typedef __bf16 bf16x2_t __attribute__((ext_vector_type(2)));
__device__ __forceinline__ unsigned cvtpk(float lo, float hi) { const f32x2 v = {lo, hi}; const bf16x2_t b = __builtin_convertvector(v, bf16x2_t); return __builtin_bit_cast(unsigned, b); }
__device__ __forceinline__ float fexp2(float x) { return __builtin_amdgcn_exp2f(x); }
__device__ __forceinline__ float flog2(float x) { return __builtin_amdgcn_logf(x); }
constexpr float LOG2E = 1.4426950408889634f;

constexpr size_t SCR_QF = 0, SCR_KF = 16 * MiB, SCR_VF = 32 * MiB, SCR_BCUM = 48 * MiB, SCR_UT = 64 * MiB, SCR_ST = 96 * MiB, SCR_BYTES = 112 * MiB;
static_assert(WS_SCR + SCR_BYTES <= WS_END, "scratch map");
__device__ __forceinline__ bf16* scr_bf(const Params& P, size_t off) { return (bf16*)(P.ws + WS_SCR + off); }
__device__ __forceinline__ float* scr_f32(const Params& P, size_t off) { return (float*)(P.ws + WS_SCR + off); }

__device__ __forceinline__ void m1_conv(const Params& P, int l, int chunk, const Ctx& C) {
    const bf16* proj = ws_proj(P); bf16* mixed = ws_mixed(P); const float* cw = P.conv_w + (size_t)l * 3 * GW;
    for (int it = C.tid; it < 64 * 64; it += 512) {
        const int m = chunk * 64 + (it >> 6), c8 = (it & 63) * 8, t = m & (SEQ - 1);
        float acc[8];
#pragma unroll
        for (int e = 0; e < 8; ++e) acc[e] = 0.f;
#pragma unroll
        for (int i = 0; i < 3; ++i) { if (t - 2 + i >= 0) {
            const u32x4 cc = *(const u32x4*)(proj + (size_t)(m - 2 + i) * NPROJ + PC_CC + c8), hh = *(const u32x4*)(proj + (size_t)(m - 2 + i) * NPROJ + PC_CH + c8);
            const f32x4 w0 = *(const f32x4*)(cw + i * GW + c8), w1 = *(const f32x4*)(cw + i * GW + c8 + 4);
            acc[0] += w0.x * bflo(cc.x) * bflo(hh.x); acc[1] += w0.y * bfhi(cc.x) * bfhi(hh.x); acc[2] += w0.z * bflo(cc.y) * bflo(hh.y); acc[3] += w0.w * bfhi(cc.y) * bfhi(hh.y);
            acc[4] += w1.x * bflo(cc.z) * bflo(hh.z); acc[5] += w1.y * bfhi(cc.z) * bfhi(hh.z); acc[6] += w1.z * bflo(cc.w) * bflo(hh.w); acc[7] += w1.w * bfhi(cc.w) * bfhi(hh.w); } }
        const u32x4 bb = *(const u32x4*)(proj + (size_t)m * NPROJ + PC_CB + c8);
        u32x4 o; o.x = pk2(bflo(bb.x) * acc[0], bfhi(bb.x) * acc[1]); o.y = pk2(bflo(bb.y) * acc[2], bfhi(bb.y) * acc[3]); o.z = pk2(bflo(bb.z) * acc[4], bfhi(bb.z) * acc[5]); o.w = pk2(bflo(bb.w) * acc[6], bfhi(bb.w) * acc[7]);
        *(u32x4*)(mixed + (size_t)m * D_MODEL + MC_CONV + c8) = o;
    }
}

constexpr int PL_STRIDE = 136;
__device__ __forceinline__ void m1_pool(const Params& P, int l, int chunk, const Ctx& C) {
    const bf16* proj = ws_proj(P); bf16* mixed = ws_mixed(P);
    LAS bf16* PLs = (LAS bf16*)C.lds;
    const int m0 = chunk * 64, t0 = m0 & (SEQ - 1);
    __syncthreads();
    { const int ch = C.tid, g = ch >> 7, c = ch & 127, w = 2 << g; const bf16* up = proj + PC_PU + ch;
      float S = 0.f;
      for (int i = 1; i < w; ++i) if (t0 - i >= 0) S += bf2f(up[(size_t)(m0 - i) * NPROJ]);
      for (int tk = 0; tk < 64; ++tk) { const int t = t0 + tk; const float u = bf2f(up[(size_t)(m0 + tk) * NPROJ]); S += u;
          const int cnt = (t + 1 < w) ? t + 1 : w; const float pooled = S / (float)cnt - u;
          PLs[(g * 64 + tk) * PL_STRIDE + c] = (bf16)f2bf(pooled);
          if (t - w + 1 >= 0) S -= bf2f(up[(size_t)(m0 + tk - w + 1) * NPROJ]); } }
    __syncthreads();
    { const int g = C.wave >> 1, nh = C.wave & 1, li = C.lane & 15, lg = C.lane >> 4;
      const bf16* pw = ws_wt(P, l, WT_PW) + (size_t)g * 128 * 128;
#pragma unroll 1
      for (int dt = 4 * nh; dt < 4 * nh + 4; ++dt) {
          bf16x8 af[4];
#pragma unroll
          for (int ks = 0; ks < 4; ++ks) af[ks] = *(const bf16x8*)(pw + (size_t)(16 * dt + li) * 128 + 32 * ks + 8 * lg);
          const f32x4 sc = *(const f32x4*)(P.pool_scale + l * GW + g * 128 + 16 * dt + 4 * lg);
#pragma unroll
          for (int tt = 0; tt < 4; ++tt) { f32x4 acc = {0.f, 0.f, 0.f, 0.f};
#pragma unroll
              for (int ks = 0; ks < 4; ++ks) { const bf16x8 bfr = *(const LAS bf16x8*)(PLs + (g * 64 + 16 * tt + li) * PL_STRIDE + 32 * ks + 8 * lg); acc = MFMA16(af[ks], bfr, acc); }
              u32x2 o; o.x = cvtpk(acc[0] * sc[0], acc[1] * sc[1]); o.y = cvtpk(acc[2] * sc[2], acc[3] * sc[3]);
              *(u32x2*)(mixed + (size_t)(m0 + 16 * tt + li) * D_MODEL + MC_POOL + g * 128 + 16 * dt + 4 * lg) = o; } } }
}

constexpr float SB_QSCALE = 0.08838834764831845f * LOG2E;
__device__ __forceinline__ void m1_sbprep(const Params& P, int l, int chunk, const Ctx& C) {
    const bf16* proj = ws_proj(P);
    LAS float* RS = (LAS float*)C.lds;
    const int m0 = chunk * 64, b = m0 >> 11, tile0 = (m0 & (SEQ - 1)) >> 5;
    __syncthreads();
#pragma unroll 1
    for (int rr = 0; rr < 64; ++rr) { const int ri = C.wave * 64 + rr, qk = ri >> 8, h = (ri >> 6) & 3, row = ri & 63;
        const unsigned v2 = *(const unsigned*)(proj + (size_t)(m0 + row) * NPROJ + (qk ? PC_SK : PC_SQ) + h * 128 + 2 * C.lane); const float a = bflo(v2), c = bfhi(v2);
        const float rs = 1.0f / sqrtf(wave_sum(a * a + c * c) * (1.0f / 128.f) + RMS_EPS);
        if (C.lane == 0) RS[ri] = rs; }
    __syncthreads();
    const float* qg = P.sb_q_g + l * 128; const float* kg = P.sb_k_g + l * 128;
#pragma unroll 1
    for (int h = 0; h < 4; ++h) { const int bh = b * 4 + h;
#pragma unroll 1
        for (int tl = 0; tl < 2; ++tl) { const size_t tbase = ((size_t)bh * 64 + tile0 + tl) * 4096;
            { const int s = C.tid >> 6, ln = C.tid & 63, row = 32 * tl + (ln & 31), d0 = 16 * s + 8 * (ln >> 5);
#pragma unroll
              for (int qk = 0; qk < 2; ++qk) { const u32x4 x = *(const u32x4*)(proj + (size_t)(m0 + row) * NPROJ + (qk ? PC_SK : PC_SQ) + h * 128 + d0);
                  const float rs = RS[qk * 256 + h * 64 + row] * (qk ? 1.0f : SB_QSCALE); const float* gp = (qk ? kg : qg) + d0; const f32x4 g0 = *(const f32x4*)gp, g1 = *(const f32x4*)(gp + 4);
                  u32x4 o; o.x = cvtpk(bflo(x.x) * rs * g0.x, bfhi(x.x) * rs * g0.y); o.y = cvtpk(bflo(x.y) * rs * g0.z, bfhi(x.y) * rs * g0.w);
                  o.z = cvtpk(bflo(x.z) * rs * g1.x, bfhi(x.z) * rs * g1.y); o.w = cvtpk(bflo(x.w) * rs * g1.z, bfhi(x.w) * rs * g1.w);
                  *(u32x4*)(scr_bf(P, qk ? SCR_KF : SCR_QF) + tbase + (size_t)C.tid * 8) = o; } }
            { const int mt = C.tid >> 7, s2 = (C.tid >> 6) & 1, ln = C.tid & 63, hh = ln >> 5, d = 32 * mt + (ln & 31); unsigned short e[8];
#pragma unroll
              for (int j = 0; j < 8; ++j) { const int key = 32 * tl + 16 * s2 + 8 * (j >> 2) + 4 * hh + (j & 3); e[j] = proj[(size_t)(m0 + key) * NPROJ + PC_SV + h * 128 + d]; }
              u32x4 o; o.x = e[0] | ((unsigned)e[1] << 16); o.y = e[2] | ((unsigned)e[3] << 16); o.z = e[4] | ((unsigned)e[5] << 16); o.w = e[6] | ((unsigned)e[7] << 16);
              *(u32x4*)(scr_bf(P, SCR_VF) + tbase + (size_t)C.tid * 8) = o; } } }
}

__device__ __forceinline__ void m2_sb(const Params& P, int l, const Ctx& C) {
    bf16* mixed = ws_mixed(P); const bf16* QF = scr_bf(P, SCR_QF); const bf16* KF = scr_bf(P, SCR_KF); const bf16* VF = scr_bf(P, SCR_VF);
    const int lane = C.lane, q = lane & 31, hi = lane >> 5;
    for (int wu = C.bid; wu < 256; wu += C.G) {
        const int bh = wu >> 3, j8 = wu & 7, strip = (C.wave < 4) ? 4 * j8 + C.wave : 63 - 4 * j8 - (C.wave - 4);
        const int b = bh >> 2, h = bh & 3;
        bf16x8 qf[8];
        { const bf16* qp = QF + ((size_t)bh * 64 + strip) * 4096 + lane * 8;
#pragma unroll
          for (int s = 0; s < 8; ++s) qf[s] = *(const bf16x8*)(qp + s * 512); }
        f32x16 O[4];
#pragma unroll
        for (int mt = 0; mt < 4; ++mt)
#pragma unroll
            for (int r = 0; r < 16; ++r) O[mt][r] = 0.f;
        float carry = 0.f;
        for (int kt = strip; kt >= 0; --kt) {
            const bf16* kp = KF + ((size_t)bh * 64 + kt) * 4096 + lane * 8; const bf16* vp = VF + ((size_t)bh * 64 + kt) * 4096 + lane * 8;
            f32x16 S;
#pragma unroll
            for (int r = 0; r < 16; ++r) S[r] = 0.f;
#pragma unroll
            for (int s = 0; s < 8; ++s) { const bf16x8 kf = *(const bf16x8*)(kp + s * 512); S = MFMA32(kf, qf[s], S); }
            const bool diag = (kt == strip);
            float ls[16], lr[16];
#pragma unroll
            for (int r = 0; r < 16; ++r) { const float z = S[r]; const int key = (r & 3) + 8 * (r >> 2) + 4 * hi; const bool valid = !diag || key < q;
                const float e = fexp2(-fabsf(z)), l2 = flog2(1.0f + e); ls[r] = fminf(z, 0.f) - l2; lr[r] = valid ? ls[r] - z : 0.f; if (!valid) ls[r] = -1e30f; }
            float gs[4], og[4];
#pragma unroll
            for (int c = 0; c < 4; ++c) { gs[c] = (lr[4 * c] + lr[4 * c + 1]) + (lr[4 * c + 2] + lr[4 * c + 3]); og[c] = __shfl_xor(gs[c], 32); }
            float R[4]; R[3] = 0.f; R[2] = gs[3] + og[3]; R[1] = R[2] + (gs[2] + og[2]); R[0] = R[1] + (gs[1] + og[1]);
            const float total = R[0] + (gs[0] + og[0]);
            unsigned pk[8];
#pragma unroll
            for (int c = 0; c < 4; ++c) { const float T = R[c] + (hi == 0 ? og[c] : 0.f) + carry;
                const float s3 = T, s2 = s3 + lr[4 * c + 3], s1 = s2 + lr[4 * c + 2], s0 = s1 + lr[4 * c + 1];
                const float a0 = fexp2(ls[4 * c] + s0), a1 = fexp2(ls[4 * c + 1] + s1), a2 = fexp2(ls[4 * c + 2] + s2), a3 = fexp2(ls[4 * c + 3] + s3);
                pk[2 * c] = cvtpk(a0, a1); pk[2 * c + 1] = cvtpk(a2, a3); }
            carry += total;
            bf16x8 p0, p1; { u32x4 w0 = {pk[0], pk[1], pk[2], pk[3]}, w1 = {pk[4], pk[5], pk[6], pk[7]}; p0 = __builtin_bit_cast(bf16x8, w0); p1 = __builtin_bit_cast(bf16x8, w1); }
#pragma unroll
            for (int mt = 0; mt < 4; ++mt) { const bf16x8 v0 = *(const bf16x8*)(vp + (mt * 2) * 512), v1 = *(const bf16x8*)(vp + (mt * 2 + 1) * 512);
                O[mt] = MFMA32(v0, p0, O[mt]); O[mt] = MFMA32(v1, p1, O[mt]); }
            if (__all(carry < -135.0f)) break;
        }
        bf16* orow = mixed + ((size_t)b * SEQ + strip * 32 + q) * D_MODEL + MC_SB + h * 128;
#pragma unroll
        for (int mt = 0; mt < 4; ++mt)
#pragma unroll
            for (int c = 0; c < 4; ++c) { u32x2 o; o.x = cvtpk(O[mt][4 * c], O[mt][4 * c + 1]); o.y = cvtpk(O[mt][4 * c + 2], O[mt][4 * c + 3]);
                *(u32x2*)(orow + 32 * mt + 8 * c + 4 * hi) = o; }
    }
}
constexpr int GK_STRIDE = 72, GV_STRIDE = 136;
__device__ __forceinline__ void m1_gla_a(const Params& P, int l, int chunk, const Ctx& C) {
    const bf16* proj = ws_proj(P); const bf16* hbuf = ws_h(P); const bf16* wa = ws_wt(P, l, WT_IN) + (size_t)NPROJ * D_MODEL;
    float* BCUM = scr_f32(P, SCR_BCUM); float* UT = scr_f32(P, SCR_UT);
    LAS float* Bc = (LAS float*)C.lds;
    LAS float* GAp = (LAS float*)(C.lds + 65536);
    LAS float* GAs = (LAS float*)(C.lds + 65536 + 32768);
    LAS float* AW = GAs + 1024;
    LAS float* AB = AW + 4096;
    LAS unsigned char* TK = C.lds + 65536;
    LAS unsigned char* TV = TK + 2 * 64 * GK_STRIDE * 2;
    const int m0 = chunk * 64, b = m0 >> 11, cc = (m0 & (SEQ - 1)) >> 6, tid = C.tid, lane = C.lane, li = lane & 15, lg = lane >> 4;
    __syncthreads();
    for (int i = tid; i < 4096; i += 512) AW[i] = P.gla_a_w[(size_t)l * 4096 + i];
    if (tid < 256) AB[tid] = P.gla_a_b[l * 256 + tid];
    { f32x4 acc[4];
#pragma unroll
      for (int mt = 0; mt < 4; ++mt) acc[mt] = (f32x4){0.f, 0.f, 0.f, 0.f};
#pragma unroll 2
      for (int kk = 0; kk < 8; ++kk) { const int ks = 8 * C.wave + kk;
          const bf16x8 bfr = *(const bf16x8*)(wa + (size_t)li * D_MODEL + 32 * ks + 8 * lg);
#pragma unroll
          for (int mt = 0; mt < 4; ++mt) { const bf16x8 afr = *(const bf16x8*)(hbuf + (size_t)(m0 + 16 * mt + li) * D_MODEL + 32 * ks + 8 * lg); acc[mt] = MFMA16(afr, bfr, acc[mt]); } }
#pragma unroll
      for (int mt = 0; mt < 4; ++mt)
#pragma unroll
          for (int r = 0; r < 4; ++r) GAp[(C.wave * 64 + 16 * mt + 4 * lg + r) * 16 + li] = acc[mt][r]; }
    __syncthreads();
    for (int o = tid; o < 1024; o += 512) { float s = 0.f;
#pragma unroll
        for (int w = 0; w < 8; ++w) s += GAp[w * 1024 + o];
        GAs[o] = s; }
    __syncthreads();
    { const int col = tid & 255, half = tid >> 8; float aw[16];
#pragma unroll
      for (int j = 0; j < 16; ++j) aw[j] = AW[j * 256 + col];
      const float ab = AB[col]; float run = 0.f;
      for (int t = 32 * half; t < 32 * half + 32; ++t) { float lg2 = ab;
#pragma unroll
          for (int j = 0; j < 16; ++j) lg2 += GAs[t * 16 + j] * aw[j];
          run += log_sigmoid(lg2) * (1.0f / 16.0f); Bc[t * 256 + col] = run; } }
    __syncthreads();
    { const int col = tid & 255, half = tid >> 8;
      if (half) { const float tot = Bc[31 * 256 + col]; for (int t = 32; t < 64; ++t) Bc[t * 256 + col] += tot; } }
    __syncthreads();
    for (int i = tid; i < 64 * 64; i += 512) { const int t = i >> 6, c4 = (i & 63) * 4; const LAS float* s = Bc + t * 256 + c4; *(f32x4*)(BCUM + (size_t)(m0 + t) * 256 + c4) = (f32x4){s[0], s[1], s[2], s[3]}; }
#pragma unroll 1
    for (int hp = 0; hp < 2; ++hp) {
        __syncthreads();
        for (int i = tid; i < 2 * 64 * 8; i += 512) { const int hs = i >> 9, t = (i >> 3) & 63, k8 = (i & 7) * 8, h = 2 * hp + hs;
            const u32x4 k4 = *(const u32x4*)(proj + (size_t)(m0 + t) * NPROJ + PC_GK + h * 64 + k8); const LAS float* bb = Bc + t * 256 + h * 64 + k8;
            u32x4 o; o.x = cvtpk(bflo(k4.x) * expf(-bb[0]), bfhi(k4.x) * expf(-bb[1])); o.y = cvtpk(bflo(k4.y) * expf(-bb[2]), bfhi(k4.y) * expf(-bb[3]));
            o.z = cvtpk(bflo(k4.z) * expf(-bb[4]), bfhi(k4.z) * expf(-bb[5])); o.w = cvtpk(bflo(k4.w) * expf(-bb[6]), bfhi(k4.w) * expf(-bb[7]));
            *(LAS u32x4*)(TK + ((hs * 64 + t) * GK_STRIDE + k8) * 2) = o; }
        for (int i = tid; i < 2 * 64 * 16; i += 512) { const int hs = i >> 10, t = (i >> 4) & 63, v8 = (i & 15) * 8, h = 2 * hp + hs;
            *(LAS u32x4*)(TV + ((hs * 64 + t) * GV_STRIDE + v8) * 2) = *(const u32x4*)(proj + (size_t)(m0 + t) * NPROJ + PC_GV + h * 128 + v8); }
        __syncthreads();
        { const int hs = C.wave >> 2, qr = C.wave & 3, h = 2 * hp + hs, bh = b * 4 + h, q4 = li >> 2, p4 = li & 3;
          const LAS unsigned char* tk = TK + hs * 64 * GK_STRIDE * 2; const LAS unsigned char* tv = TV + hs * 64 * GV_STRIDE * 2;
          f32x4 acc[2][4];
#pragma unroll
          for (int a = 0; a < 2; ++a)
#pragma unroll
              for (int n = 0; n < 4; ++n) acc[a][n] = (f32x4){0.f, 0.f, 0.f, 0.f};
#pragma unroll
          for (int ks = 0; ks < 2; ++ks) { const int trow = 32 * ks + 8 * lg + q4;
              bf16x8 bfr[4];
#pragma unroll
              for (int n = 0; n < 4; ++n) bfr[n] = cat8(lds_tr(tk + (trow * GK_STRIDE + 16 * n + 4 * p4) * 2), lds_tr(tk + ((trow + 4) * GK_STRIDE + 16 * n + 4 * p4) * 2));
#pragma unroll
              for (int a = 0; a < 2; ++a) { const int v0 = 16 * (2 * qr + a);
                  const bf16x8 afr = cat8(lds_tr(tv + (trow * GV_STRIDE + v0 + 4 * p4) * 2), lds_tr(tv + ((trow + 4) * GV_STRIDE + v0 + 4 * p4) * 2));
#pragma unroll
                  for (int n = 0; n < 4; ++n) acc[a][n] = MFMA16(afr, bfr[n], acc[a][n]); } }
          float* ut = UT + ((size_t)bh * 32 + cc) * 8192;
#pragma unroll
          for (int a = 0; a < 2; ++a)
#pragma unroll
              for (int n = 0; n < 4; ++n)
#pragma unroll
                  for (int r = 0; r < 4; ++r) ut[(16 * (2 * qr + a) + 4 * lg + r) * 64 + 16 * n + li] = acc[a][n][r]; }
    }
}

__device__ __forceinline__ void m2_gla_scan(const Params& P, const Ctx& C) {
    const float* BCUM = scr_f32(P, SCR_BCUM); const float* UT = scr_f32(P, SCR_UT); bf16* ST = scr_bf(P, SCR_ST);
    for (int e = C.bid * 512 + C.tid; e < 32 * 128 * 32; e += C.G * 512) {
        const int bh = e >> 12, v = (e >> 5) & 127, k2 = (e & 31) * 2, b = bh >> 2, h = bh & 3;
        float s0 = 0.f, s1 = 0.f;
#pragma unroll 4
        for (int c = 0; c < 32; ++c) { const size_t uo = (((size_t)bh * 32 + c) * 128 + v) * 64 + k2;
            const f32x2 u = *(const f32x2*)(UT + uo); const f32x2 bl = *(const f32x2*)(BCUM + ((size_t)b * SEQ + 64 * c + 63) * 256 + h * 64 + k2);
            *(unsigned*)(ST + uo) = cvtpk(s0, s1);
            s0 = expf(bl.x) * (s0 + u.x); s1 = expf(bl.y) * (s1 + u.y); }
    }
}

__device__ __forceinline__ void m3_gla_c(const Params& P, int l, const Ctx& C) {
    const bf16* proj = ws_proj(P); bf16* mixed = ws_mixed(P); const float* BCUM = scr_f32(P, SCR_BCUM); const bf16* ST = scr_bf(P, SCR_ST);
    const float* ng = P.gla_norm_g + l * 128;
    LAS unsigned char* TQ = C.lds;
    LAS unsigned char* TK = TQ + 2 * 64 * GK_STRIDE * 2;
    LAS unsigned char* TV = TK + 2 * 64 * GK_STRIDE * 2;
    const int tid = C.tid, lane = C.lane, li = lane & 15, lg = lane >> 4, q4 = li >> 2, p4 = li & 3;
    for (int unit = C.bid; unit < 512; unit += C.G) {
        const int chunk = unit >> 1, hp = unit & 1, m0 = chunk * 64, b = m0 >> 11, cc = (m0 & (SEQ - 1)) >> 6;
        __syncthreads();
        for (int i = tid; i < 2 * 64 * 8; i += 512) { const int hs = i >> 9, t = (i >> 3) & 63, k8 = (i & 7) * 8, h = 2 * hp + hs;
            const u32x4 q4v = *(const u32x4*)(proj + (size_t)(m0 + t) * NPROJ + PC_GQ + h * 64 + k8), k4 = *(const u32x4*)(proj + (size_t)(m0 + t) * NPROJ + PC_GK + h * 64 + k8);
            const float* bp = BCUM + (size_t)(m0 + t) * 256 + h * 64 + k8; const f32x4 b0 = *(const f32x4*)bp, b1 = *(const f32x4*)(bp + 4);
            float ep[8], en[8]; const float bb[8] = {b0.x, b0.y, b0.z, b0.w, b1.x, b1.y, b1.z, b1.w};
#pragma unroll
            for (int j = 0; j < 8; ++j) { ep[j] = expf(bb[j]) * 0.125f; en[j] = expf(-bb[j]); }
            u32x4 oq, ok;
            oq.x = cvtpk(bflo(q4v.x) * ep[0], bfhi(q4v.x) * ep[1]); oq.y = cvtpk(bflo(q4v.y) * ep[2], bfhi(q4v.y) * ep[3]); oq.z = cvtpk(bflo(q4v.z) * ep[4], bfhi(q4v.z) * ep[5]); oq.w = cvtpk(bflo(q4v.w) * ep[6], bfhi(q4v.w) * ep[7]);
            ok.x = cvtpk(bflo(k4.x) * en[0], bfhi(k4.x) * en[1]); ok.y = cvtpk(bflo(k4.y) * en[2], bfhi(k4.y) * en[3]); ok.z = cvtpk(bflo(k4.z) * en[4], bfhi(k4.z) * en[5]); ok.w = cvtpk(bflo(k4.w) * en[6], bfhi(k4.w) * en[7]);
            *(LAS u32x4*)(TQ + ((hs * 64 + t) * GK_STRIDE + k8) * 2) = oq; *(LAS u32x4*)(TK + ((hs * 64 + t) * GK_STRIDE + k8) * 2) = ok; }
        for (int i = tid; i < 2 * 64 * 16; i += 512) { const int hs = i >> 10, t = (i >> 4) & 63, v8 = (i & 15) * 8, h = 2 * hp + hs;
            *(LAS u32x4*)(TV + ((hs * 64 + t) * GV_STRIDE + v8) * 2) = *(const u32x4*)(proj + (size_t)(m0 + t) * NPROJ + PC_GV + h * 128 + v8); }
        __syncthreads();
        const int hs = C.wave >> 2, tt = C.wave & 3, h = 2 * hp + hs, bh = b * 4 + h;
        const LAS unsigned char* tq = TQ + hs * 64 * GK_STRIDE * 2; const LAS unsigned char* tk = TK + hs * 64 * GK_STRIDE * 2; const LAS unsigned char* tv = TV + hs * 64 * GV_STRIDE * 2;
        bf16x8 bq[2];
#pragma unroll
        for (int ks = 0; ks < 2; ++ks) bq[ks] = *(const LAS bf16x8*)(tq + ((16 * tt + li) * GK_STRIDE + 32 * ks + 8 * lg) * 2);
        bf16x8 bp[2];
#pragma unroll
        for (int kb = 0; kb < 2; ++kb) { unsigned w[4] = {0u, 0u, 0u, 0u};
            if (2 * kb <= tt) {
#pragma unroll
                for (int x = 0; x < 2; ++x) { const int st = 2 * kb + x; f32x4 a = {0.f, 0.f, 0.f, 0.f};
                    if (st <= tt) {
#pragma unroll
                        for (int ks = 0; ks < 2; ++ks) { const bf16x8 ak = *(const LAS bf16x8*)(tk + ((16 * st + li) * GK_STRIDE + 32 * ks + 8 * lg) * 2); a = MFMA16(ak, bq[ks], a); }
                        if (st == tt) {
#pragma unroll
                            for (int r = 0; r < 4; ++r) if (4 * lg + r > li) a[r] = 0.f; } }
                    w[2 * x] = cvtpk(a[0], a[1]); w[2 * x + 1] = cvtpk(a[2], a[3]); } }
            u32x4 wv = {w[0], w[1], w[2], w[3]}; bp[kb] = __builtin_bit_cast(bf16x8, wv); }
        f32x4 acc[8];
#pragma unroll
        for (int mv = 0; mv < 8; ++mv) acc[mv] = (f32x4){0.f, 0.f, 0.f, 0.f};
        const bf16* st_base = ST + ((size_t)bh * 32 + cc) * 8192;
#pragma unroll
        for (int mv = 0; mv < 8; ++mv) {
#pragma unroll
            for (int ks = 0; ks < 2; ++ks) { const bf16x8 as = *(const bf16x8*)(st_base + (size_t)(16 * mv + li) * 64 + 32 * ks + 8 * lg); acc[mv] = MFMA16(as, bq[ks], acc[mv]); }
#pragma unroll
            for (int kb = 0; kb < 2; ++kb) { if (2 * kb <= tt) { const int r0 = 32 * kb + 4 * lg + q4;
                const bf16x8 av = cat8(lds_tr(tv + (r0 * GV_STRIDE + 16 * mv + 4 * p4) * 2), lds_tr(tv + ((r0 + 16) * GV_STRIDE + 16 * mv + 4 * p4) * 2));
                acc[mv] = MFMA16(av, bp[kb], acc[mv]); } } }
        float ss = 0.f;
#pragma unroll
        for (int mv = 0; mv < 8; ++mv) ss += (acc[mv][0] * acc[mv][0] + acc[mv][1] * acc[mv][1]) + (acc[mv][2] * acc[mv][2] + acc[mv][3] * acc[mv][3]);
        ss += __shfl_xor(ss, 16); ss += __shfl_xor(ss, 32);
        const float rstd = 1.0f / sqrtf(ss * (1.0f / 128.f) + RMS_EPS);
        const size_t mrow = (size_t)(m0 + 16 * tt + li);
#pragma unroll
        for (int mv = 0; mv < 8; ++mv) { const int v4 = 16 * mv + 4 * lg; const f32x4 g4 = *(const f32x4*)(ng + v4);
            const u32x2 r2 = *(const u32x2*)(proj + mrow * NPROJ + PC_GR + h * 128 + v4); const float rr[4] = {bflo(r2.x), bfhi(r2.x), bflo(r2.y), bfhi(r2.y)}; float y[4];
#pragma unroll
            for (int r = 0; r < 4; ++r) y[r] = acc[mv][r] * rstd * g4[r] * rr[r] * __builtin_amdgcn_rcpf(1.0f + fexp2(-LOG2E * rr[r]));
            u32x2 o; o.x = cvtpk(y[0], y[1]); o.y = cvtpk(y[2], y[3]);
            *(u32x2*)(mixed + mrow * D_MODEL + MC_GLA + h * 128 + v4) = o; }
    }
}
__device__ __forceinline__ void ph_gemm(const Params& P, int l, int s, const Ctx& C) {
    pg8::Gemm g; pg8::EpiAny E;
    if (s == 0)      { g = pg8::Gemm{ws_h(P), ws_wt(P, l, WT_IN), MTOK, NPROJ, D_MODEL};      E = pg8::EpiAny{0, ws_proj(P), nullptr, nullptr, NPROJ}; }
    else if (s == 1) { g = pg8::Gemm{ws_mixed(P), ws_wt(P, l, WT_OUT), MTOK, D_MODEL, D_MODEL}; E = pg8::EpiAny{1, nullptr, l == 0 ? P.x : P.out, P.out, D_MODEL}; }
    else if (s == 2) { g = pg8::Gemm{ws_h(P), ws_wt(P, l, WT_GU), MTOK, NGU, D_MODEL};        E = pg8::EpiAny{2, ws_ff(P), nullptr, nullptr, DFF}; }
    else             { g = pg8::Gemm{ws_ff(P), ws_wt(P, l, WT_DN), MTOK, D_MODEL, DFF};       E = pg8::EpiAny{1, nullptr, P.out, P.out, D_MODEL}; }
    pg8::StaticOrder S; S.init(g.M, g.N, C.G, C.bid);
    pg8::gemm_phase<pg8::EpiAny, pg8::StaticOrder, true, true>(C.lds, g, S, E);
}

#define XB_TMO      128
#define XB_XCNT(j)  (256  + 64 * (j))
#define XB_XSUB(j)  (1280 + 64 * (j))
#define XB_XGEN(j)  (2304 + 64 * (j))
#define XB_TOP      3328
#define XB_TOPGEN   3392
#define XCD_BAR_WORDS 3456
#define XB_SPIN_CAP (1u << 18)

__device__ __forceinline__ unsigned xb_ld(unsigned* p)              { return __hip_atomic_load(p, __ATOMIC_RELAXED, __HIP_MEMORY_SCOPE_AGENT); }
__device__ __forceinline__ unsigned xb_add(unsigned* p, unsigned v) { return __hip_atomic_fetch_add(p, v, __ATOMIC_RELAXED, __HIP_MEMORY_SCOPE_AGENT); }
__device__ __forceinline__ unsigned xb_xcc_id() { return (unsigned)__builtin_amdgcn_s_getreg((3 << 11) | 20) & 0xFu; }
#define XB_SPIN(cond, bar) do { unsigned _sp = 0; while (cond) { __builtin_amdgcn_s_sleep(1); \
    if ((++_sp & 255u) == 0u) { if (xb_ld(&(bar)[XB_TMO])) break; if (_sp > XB_SPIN_CAP) { atomicAdd(&(bar)[XB_TMO], 1u); break; } } } } while (0)

struct XcdBarrier {
    unsigned* bar; unsigned x;
    volatile LAS unsigned* st;
};

__device__ __forceinline__ XcdBarrier xcd_barrier_post(unsigned* bar, volatile LAS unsigned* st) {
    XcdBarrier b; b.bar = bar; b.x = xb_xcc_id(); b.st = st;
    if (threadIdx.x == 0) (void)xb_add(&bar[XB_XCNT(b.x)], 1u);
    return b;
}
__device__ __forceinline__ void xcd_barrier_complete(unsigned* bar, unsigned x, unsigned& nloc, unsigned& nx) {
    const unsigned G = gridDim.x * gridDim.y * gridDim.z;
    unsigned sum, cnt, mine, sp = 0u;
    for (;;) {
        sum = 0u; cnt = 0u; mine = 0u;
#pragma unroll
        for (unsigned j = 0; j < 16; ++j) { const unsigned c = xb_ld(&bar[XB_XCNT(j)]); sum += c; cnt += (c > 0u) ? 1u : 0u; mine = (j == x) ? c : mine; }
        if (sum == G) break;
        __builtin_amdgcn_s_sleep(1);
        if ((++sp & 255u) == 0u) { if (xb_ld(&bar[XB_TMO])) break; if (sp > XB_SPIN_CAP) { atomicAdd(&bar[XB_TMO], 1u); break; } }
    }
    nloc = mine > 0u ? mine : 1u; nx = cnt > 0u ? cnt : 1u;
}

__device__ __forceinline__ void xcd_barrier(const XcdBarrier& b) {
    asm volatile("s_waitcnt vmcnt(0)" ::: "memory");
    __syncthreads();
    if (threadIdx.x == 0) {
        unsigned* bar = b.bar;
        __builtin_amdgcn_s_waitcnt(0);
        unsigned nloc = b.st[0], nx = b.st[1];
        if (nloc == 0u) { xcd_barrier_complete(bar, b.x, nloc, nx); b.st[0] = nloc; b.st[1] = nx; }
        const unsigned old = xb_add(&bar[XB_XSUB(b.x)], 1u);
        const unsigned gen = old / nloc;
        if (old + 1u == (gen + 1u) * nloc) {
            __builtin_amdgcn_fence(__ATOMIC_RELEASE, "agent");
            asm volatile("s_waitcnt vmcnt(0)" ::: "memory");
            const unsigned og = xb_add(&bar[XB_TOP], 1u);
            const unsigned tg = og / nx;
            if (og + 1u == (tg + 1u) * nx) xb_add(&bar[XB_TOPGEN], 1u);
            else XB_SPIN(xb_ld(&bar[XB_TOPGEN]) == tg, bar);
            __builtin_amdgcn_fence(__ATOMIC_ACQUIRE, "agent");
            xb_add(&bar[XB_XGEN(b.x)], 1u);
            asm volatile("s_waitcnt vmcnt(0)" ::: "memory");
        } else {
            XB_SPIN(xb_ld(&bar[XB_XGEN(b.x)]) == gen, bar);
            __builtin_amdgcn_fence(__ATOMIC_ACQUIRE, "agent");
            asm volatile("s_waitcnt vmcnt(0)" ::: "memory");
        }
    }
    __syncthreads();
}


constexpr int LDS_BYTES = 147456;
constexpr int MISC_OFF = LDS_BYTES - 256;
constexpr int CW_BAR = 4096;
__global__ void __launch_bounds__(512, 2) mk_fwd(Params P) {
    extern __shared__ __attribute__((aligned(16))) unsigned char lds[];
    Ctx C; C.lds = (LAS unsigned char*)lds; C.tid = threadIdx.x; C.lane = C.tid & 63; C.wave = __builtin_amdgcn_readfirstlane(C.tid >> 6); C.bid = blockIdx.x; C.G = gridDim.x;
    volatile LAS unsigned* MISC = (volatile LAS unsigned*)(C.lds + MISC_OFF);
    if (C.tid < 64) MISC[C.tid] = 0u;
    __syncthreads();
    XcdBarrier bar = xcd_barrier_post((unsigned*)(P.ws + WS_CTL) + CW_BAR, MISC);
    bar.x = (unsigned)__builtin_amdgcn_readfirstlane((int)bar.x);
#define GRID_BAR() do { XcdBarrier b_ = bar; asm volatile("" : "+s"(b_.x), "+s"(b_.bar)); xcd_barrier(b_); } while (0)

    ph_convert(P, C);
    GRID_BAR();
#define FRESH(Cn) Ctx Cn = C; { int t_ = C.tid; asm volatile("" : "+v"(t_)); Cn.tid = t_; Cn.lane = t_ & 63; }
#ifndef SB_OPT
#define SB_OPT 1
#endif
#ifndef GLA_OPT
#define GLA_OPT 1
#endif
#ifndef POOL_OPT
#define POOL_OPT 1
#endif
#pragma unroll 1
    for (int l = 0; l < DEPTH; ++l) {
#pragma unroll 1
        for (int s = 0; s < 4; ++s) {
            if (s == 0) {
                { FRESH(C1); ph_rmsnorm(l == 0 ? P.x : P.out, P.norm1_g + l * D_MODEL, ws_h(P), C1); }
#if !GLA_OPT
                VM_WAIT(); __syncthreads();
                { FRESH(C1); ph_ga_naive(P, l, C1); }
#endif
            } else if (s == 1) {
#pragma unroll 1
                for (int chunk = C.bid; chunk < MTOK / 64; chunk += C.G) {
                    { FRESH(C1); m1_conv(P, l, chunk, C1); }
#if POOL_OPT
                    { FRESH(C1); m1_pool(P, l, chunk, C1); }
#endif
#if SB_OPT
                    { FRESH(C1); m1_sbprep(P, l, chunk, C1); }
#endif
#if GLA_OPT
                    { FRESH(C1); m1_gla_a(P, l, chunk, C1); }
#endif
                }
#if !POOL_OPT
                { FRESH(C1); ph_pool_naive(P, l, C1); }
#endif
#if !GLA_OPT
                { FRESH(C1); ph_gla_naive(P, l, C1); }
#endif
#if !SB_OPT
                { FRESH(C1); ph_sb_naive(P, l, C1); }
#endif
#if SB_OPT || GLA_OPT
                GRID_BAR();
#endif
#if GLA_OPT
                { FRESH(C1); m2_gla_scan(P, C1); }
#endif
#if SB_OPT
                { FRESH(C1); m2_sb(P, l, C1); }
#endif
#if GLA_OPT
                GRID_BAR();
                { FRESH(C1); m3_gla_c(P, l, C1); }
#endif
            } else if (s == 2) {
                { FRESH(C1); ph_rmsnorm(P.out, P.norm2_g + l * D_MODEL, ws_h(P), C1); }
            }
            if (s != 3) GRID_BAR();
            { FRESH(C1); ph_gemm(P, l, s, C1); }
            if (l + 1 < DEPTH || s != 3) GRID_BAR();
        }
    }
}

extern "C" void kernel_launch(void* const* d_in, const int* in_sizes, int n_in, void* d_out, int out_size, void* d_ws, size_t ws_size, hipStream_t stream) {
    static int grid = 0;
    if (grid == 0) {
        if (n_in != 16 || in_sizes[0] != MTOK * D_MODEL || out_size != MTOK * D_MODEL || ws_size < WS_END) {
            fprintf(stderr, "kernel_launch: unexpected shapes / workspace: n_in %d in0 %d out %d ws %zu (need %zu); nothing launched\n", n_in, n_in > 0 ? in_sizes[0] : -1, out_size, ws_size, (size_t)WS_END); grid = -1; return; }
        int dev = 0, cus = 0, per_cu = 0;
        if (hipGetDevice(&dev) != hipSuccess || hipDeviceGetAttribute(&cus, hipDeviceAttributeMultiprocessorCount, dev) != hipSuccess) { fprintf(stderr, "kernel_launch: device query failed\n"); grid = -1; return; }
        if (hipFuncSetAttribute((const void*)mk_fwd, hipFuncAttributeMaxDynamicSharedMemorySize, LDS_BYTES) != hipSuccess) { fprintf(stderr, "kernel_launch: hipFuncSetAttribute failed\n"); grid = -1; return; }
        if (hipOccupancyMaxActiveBlocksPerMultiprocessor(&per_cu, (const void*)mk_fwd, 512, LDS_BYTES) != hipSuccess || per_cu < 1) { fprintf(stderr, "kernel_launch: occupancy query says %d blocks per CU\n", per_cu); (void)hipGetLastError(); }
        grid = cus;
    }
    if (grid < 0) return;
    if (hipMemsetAsync((char*)d_ws + WS_CTL, 0, 65536, stream) != hipSuccess) { fprintf(stderr, "kernel_launch: memset failed\n"); return; }
    Params P{};
    P.x = (const float*)d_in[0]; P.norm1_g = (const float*)d_in[1]; P.w_in = (const float*)d_in[2]; P.conv_w = (const float*)d_in[3]; P.sb_q_g = (const float*)d_in[4]; P.sb_k_g = (const float*)d_in[5];
    P.gla_a_w = (const float*)d_in[6]; P.gla_a_b = (const float*)d_in[7]; P.gla_norm_g = (const float*)d_in[8]; P.pool_w = (const float*)d_in[9]; P.pool_scale = (const float*)d_in[10];
    P.w_out = (const float*)d_in[11]; P.norm2_g = (const float*)d_in[12]; P.w_gate = (const float*)d_in[13]; P.w_up = (const float*)d_in[14]; P.w_down = (const float*)d_in[15];
    P.out = (float*)d_out; P.ws = (unsigned char*)d_ws;
    hipLaunchKernelGGL(mk_fwd, dim3(grid), dim3(512), LDS_BYTES, stream, P);
    const hipError_t le = hipPeekAtLastError();
    if (le != hipSuccess) fprintf(stderr, "kernel_launch: launch failed: %s\n", hipGetErrorName(le));
}
```

```cpp
#include <hip/hip_runtime.h>
#include <cstdio>
#include <cstdint>

#define LAS __attribute__((address_space(3)))
typedef unsigned short bf16;
typedef float f32x4 __attribute__((ext_vector_type(4)));
typedef float f32x2 __attribute__((ext_vector_type(2)));
typedef unsigned u32x4 __attribute__((ext_vector_type(4)));
typedef unsigned u32x2 __attribute__((ext_vector_type(2)));
typedef short bf16x8 __attribute__((ext_vector_type(8)));

constexpr int D_MODEL = 2048, BATCH = 8, SEQ = 2048, DEPTH = 4, MTOK = BATCH * SEQ;
constexpr int GW = 512, IN_COLS = 5136, NPROJ = 5120, DFF = 5632, NGU = 2 * DFF;
constexpr float RMS_EPS = 1e-6f;
constexpr int PROJ_LD = DFF;
constexpr int PC_CB = 0, PC_CC = 512, PC_CH = 1024, PC_SQ = 1536, PC_SK = 2048, PC_SV = 2560, PC_GQ = 3072, PC_GK = 3328, PC_GV = 3584, PC_GR = 4096, PC_PU = 4608;
constexpr int MC_CONV = 0, MC_SB = 512, MC_GLA = 1024, MC_POOL = 1536;

constexpr size_t MiB = 1u << 20;
constexpr size_t WS_CTL = 0, CTL_BYTES = 1 * MiB;
constexpr size_t WS_WT = 1 * MiB;
constexpr size_t WT_IN = 0, WT_OUT = 21 * MiB, WT_GU = 29 * MiB, WT_DN = 73 * MiB, WT_PW = 95 * MiB, WT_STRIDE = 96 * MiB;
static_assert((size_t)(NPROJ + 16) * D_MODEL * 2 <= WT_OUT && (size_t)NGU * D_MODEL * 2 == 44 * MiB && (size_t)D_MODEL * DFF * 2 == 22 * MiB, "weight map");
constexpr size_t WS_H = WS_WT + DEPTH * WT_STRIDE;
constexpr size_t WS_PROJ = WS_H + 64 * MiB;
constexpr size_t WS_MIXED = WS_PROJ + 176 * MiB;
constexpr size_t WS_GA = WS_MIXED + 64 * MiB;
constexpr size_t WS_SCR = WS_GA + 1 * MiB;
constexpr size_t WS_END = WS_SCR + 112 * MiB;
constexpr long long KF_DELTA = ((long long)(WS_SCR + 16 * MiB) - (long long)WS_PROJ) / 2;

struct Params {
    const float* x; const float* norm1_g; const float* w_in; const float* conv_w; const float* sb_q_g; const float* sb_k_g;
    const float* gla_a_w; const float* gla_a_b; const float* gla_norm_g; const float* pool_w; const float* pool_scale;
    const float* w_out; const float* norm2_g; const float* w_gate; const float* w_up; const float* w_down;
    float* out; unsigned char* ws;
};

#define LDS_WAIT() asm volatile("s_waitcnt lgkmcnt(0)" ::: "memory")
#define VM_WAIT() asm volatile("s_waitcnt vmcnt(0)" ::: "memory")
__device__ __forceinline__ float bf2f(unsigned b) { return __uint_as_float(b << 16); }
__device__ __forceinline__ float bflo(unsigned w) { return __uint_as_float(w << 16); }
__device__ __forceinline__ float bfhi(unsigned w) { return __uint_as_float(w & 0xffff0000u); }
__device__ __forceinline__ unsigned f2bf(float f) { unsigned u = __float_as_uint(f); return (u + 0x7fffu + ((u >> 16) & 1u)) >> 16; }
__device__ __forceinline__ unsigned pk2(float lo, float hi) { return f2bf(lo) | (f2bf(hi) << 16); }
__device__ __forceinline__ float wave_sum(float v) {
#pragma unroll
    for (int o = 1; o < 64; o <<= 1) v += __shfl_xor(v, o);
    return v;
}

struct Ctx { LAS unsigned char* lds; int tid, lane, wave, bid, G, grp, rk; };
namespace pg8 {
#define PG8_LAS __attribute__((address_space(3)))
typedef unsigned short bf16_t;
typedef short bf16x8 __attribute__((ext_vector_type(8)));
typedef float f32x4 __attribute__((ext_vector_type(4)));
typedef unsigned u32x4 __attribute__((ext_vector_type(4)));
constexpr int BM = 256, BK = 64, HALF = 128, HTB = HALF * BK * 2  , STAGE_BYTES = 8 * HTB, NXCD = 8, WGM = 8;

__host__ __device__ __forceinline__ int lds_byte(int r, int c) { const int st = (r >> 4) * 2 + (c >> 5), rr = r & 15, cc = c & 31, ob = rr * 64 + cc * 2; return st * 1024 + (ob ^ (((ob >> 9) & 1) << 5)); }
__host__ __device__ __forceinline__ void stage_rc(int b, int& R, int& C) { const int st = b / 1024, sb = b % 1024, swz = sb ^ (((sb >> 9) & 1) << 5); R = (st >> 1) * 16 + swz / 64; C = (st & 1) * 32 + (swz % 64) / 2; }
__host__ __device__ __forceinline__ int perm32(int rho) { const int n = rho >> 4, i = rho & 15; return 8 * (i >> 2) + 4 * n + (i & 3); }

struct Unit { int pm, pn; };
struct Gemm { const bf16_t* A; const bf16_t* Bt; int M, N, K; };

struct StaticOrder {
    int nM, nN, nwg, G, c;
    __host__ __device__ void init(int M, int N, int G_, int c_) { nM = M / BM; nN = N / BM; nwg = nM * nN; G = G_; c = c_; }
    __host__ __device__ bool next(int i, Unit& u) const {
        const long L = (long)i * G + c; if (L >= nwg) return false;
        int wgid = (int)L; { const int q = nwg / NXCD, r = nwg % NXCD, xcd = wgid % NXCD, off = wgid / NXCD; wgid = (xcd < r ? xcd * (q + 1) : r * (q + 1) + (xcd - r) * q) + off; }
        const int nig = WGM * nN, gid = wgid / nig, fm = gid * WGM, gsz = (nM - fm) < WGM ? (nM - fm) : WGM;
        u.pm = fm + ((wgid % nig) % gsz); u.pn = (wgid % nig) / gsz; return true;
    }
    __device__ __forceinline__ void a_ready(const Unit&) const {}
    __device__ __forceinline__ void done(const Unit&) const {}
};

struct GroupOrder {
    int nN, grp, rk;
    __host__ __device__ bool next(int i, Unit& u) const { const int L = i * 32 + rk; if (L >= 8 * nN) return false; u.pm = 8 * grp + (L & 7); u.pn = L >> 3; return true; }
    __device__ __forceinline__ void a_ready(const Unit&) const {}
    __device__ __forceinline__ void done(const Unit&) const {}
};

__device__ __forceinline__ unsigned cvt_pk_bf16(float lo, float hi) { unsigned r; asm volatile("v_cvt_pk_bf16_f32 %0, %1, %2" : "=v"(r) : "v"(lo), "v"(hi)); return r; }

__device__ __forceinline__ float silu_mul(float g, float u) { return g * u * __builtin_amdgcn_rcpf(1.0f + __builtin_amdgcn_exp2f(-1.4426950408889634f * g)); }
struct EpiAny {
    static constexpr bool AFTER_DRAIN = false;
    int mode; bf16_t* O; bf16_t* XB; float* out; int ldc; const unsigned long long* rss_in; unsigned long long* rss_out; const PG8_LAS float* rs_lds; int pm0;
    __device__ __forceinline__ bool perm() const { return true; }
    __device__ __forceinline__ void operator()(const f32x4 (&acc)[2][2][4][2], const Unit& u, int wr, int wc, int fr, int fq) const {
        int pm_ = u.pm; asm volatile("" : "+s"(pm_));
        const int row0 = pm_ * BM + wr * 64 + fr;
        if (mode == 1) {
            const int col0 = u.pn * BM + wc * 32 + 8 * fq;
#pragma unroll
            for (int ai = 0; ai < 2; ++ai)
#pragma unroll
                for (int m = 0; m < 4; ++m) { const int row = row0 + ai * HALF + m * 16; const size_t off = (size_t)row * ldc + col0; float ss = 0.f;
#pragma unroll
                    for (int bj = 0; bj < 2; ++bj) { const u32x4 xb = *(const u32x4*)(XB + off + bj * HALF);
                        const f32x4 b0 = {__uint_as_float(xb.x << 16), __uint_as_float(xb.x & 0xffff0000u), __uint_as_float(xb.y << 16), __uint_as_float(xb.y & 0xffff0000u)};
                        const f32x4 b1 = {__uint_as_float(xb.z << 16), __uint_as_float(xb.z & 0xffff0000u), __uint_as_float(xb.w << 16), __uint_as_float(xb.w & 0xffff0000u)};
                        const f32x4 x0 = b0 + acc[ai][bj][m][0], x1 = b1 + acc[ai][bj][m][1];
                        if (out) { *(f32x4*)(out + off + bj * HALF) = x0; *(f32x4*)(out + off + bj * HALF + 4) = x1; }
                        else { u32x4 w; w.x = cvt_pk_bf16(x0[0], x0[1]); w.y = cvt_pk_bf16(x0[2], x0[3]); w.z = cvt_pk_bf16(x1[0], x1[1]); w.w = cvt_pk_bf16(x1[2], x1[3]);
                            *(u32x4*)(XB + off + bj * HALF) = w;
                            const float r0 = __uint_as_float(w.x << 16), r1 = __uint_as_float(w.x & 0xffff0000u), r2 = __uint_as_float(w.y << 16), r3 = __uint_as_float(w.y & 0xffff0000u);
                            const float r4 = __uint_as_float(w.z << 16), r5 = __uint_as_float(w.z & 0xffff0000u), r6 = __uint_as_float(w.w << 16), r7 = __uint_as_float(w.w & 0xffff0000u);
                            ss += (r0 * r0 + r1 * r1) + (r2 * r2 + r3 * r3) + (r4 * r4 + r5 * r5) + (r6 * r6 + r7 * r7); } }
                    if (!out) { ss += __shfl_xor(ss, 16); ss += __shfl_xor(ss, 32); if (fq == 0) __hip_atomic_fetch_add(rss_out + row, (unsigned long long)(ss * 1048576.0f + 0.5f), __ATOMIC_RELAXED, __HIP_MEMORY_SCOPE_AGENT); }
                    asm volatile("" ::: "memory"); }
        } else {
            float rs[2][4];
            if (pm_ == pm0) {
#pragma unroll
                for (int ai = 0; ai < 2; ++ai)
#pragma unroll
                    for (int m = 0; m < 4; ++m) rs[ai][m] = rs_lds[wr * 64 + fr + ai * HALF + m * 16];
            } else {
#pragma unroll
                for (int ai = 0; ai < 2; ++ai)
#pragma unroll
                    for (int m = 0; m < 4; ++m) rs[ai][m] = 1.0f / sqrtf((float)__hip_atomic_load(rss_in + row0 + ai * HALF + m * 16, __ATOMIC_RELAXED, __HIP_MEMORY_SCOPE_AGENT) * (1.0f / (2048.0f * 1048576.0f)) + 1e-6f);
            }
            const bool prod = mode == 0 && (unsigned)(u.pn - 2) < 4u;
            if (mode == 0 && !prod) {
                const int col0 = u.pn * BM + wc * 32 + 8 * fq;
                const bool kfr = (unsigned)(u.pn - 8) < 2u;
                const int colk = (u.pn - 8) * 524288 + (2 * wc + (fq >> 1)) * 512 + (fq & 1) * 256; const int bjs = kfr ? 262144 : HALF;
#pragma unroll
                for (int ai = 0; ai < 2; ++ai)
#pragma unroll
                    for (int m = 0; m < 4; ++m) { const int row = row0 + ai * HALF + m * 16; const float r = rs[ai][m];
                        bf16_t* rowp = O + (kfr ? (size_t)KF_DELTA + (size_t)(row >> 11) * 1048576 + (size_t)(((row >> 5) & 63) * 4096 + (row & 31) * 8 + colk) : (size_t)row * ldc + col0);
#pragma unroll
                        for (int bj = 0; bj < 2; ++bj) { const f32x4 v0 = acc[ai][bj][m][0] * r, v1 = acc[ai][bj][m][1] * r;
                            u32x4 w; w.x = cvt_pk_bf16(v0[0], v0[1]); w.y = cvt_pk_bf16(v0[2], v0[3]); w.z = cvt_pk_bf16(v1[0], v1[1]); w.w = cvt_pk_bf16(v1[2], v1[3]);
                            *(u32x4*)(rowp + bj * bjs) = w; } }
            } else if (prod) {
                const int col0 = PC_CC + (u.pn - 2) * HALF + wc * 32 + 8 * fq;
#pragma unroll
                for (int ai = 0; ai < 2; ++ai)
#pragma unroll
                    for (int m = 0; m < 4; ++m) { bf16_t* rowp = O + (size_t)(row0 + ai * HALF + m * 16) * ldc + col0; const float r2 = rs[ai][m] * rs[ai][m];
                        const f32x4 p0 = acc[ai][0][m][0] * acc[ai][1][m][0] * r2, p1 = acc[ai][0][m][1] * acc[ai][1][m][1] * r2;
                        u32x4 w; w.x = cvt_pk_bf16(p0[0], p0[1]); w.y = cvt_pk_bf16(p0[2], p0[3]); w.z = cvt_pk_bf16(p1[0], p1[1]); w.w = cvt_pk_bf16(p1[2], p1[3]);
                        *(u32x4*)rowp = w; }
            } else {
                const int col0 = u.pn * HALF + wc * 32 + 8 * fq;
#pragma unroll
                for (int ai = 0; ai < 2; ++ai)
#pragma unroll
                    for (int m = 0; m < 4; ++m) { bf16_t* rowp = O + (size_t)(row0 + ai * HALF + m * 16) * ldc + col0; const float r = rs[ai][m];
                        const float nr = -1.4426950408889634f * r, ir2 = __builtin_amdgcn_rcpf(r * r);
                        const f32x4 p0 = acc[ai][0][m][0] * acc[ai][1][m][0], p1 = acc[ai][0][m][1] * acc[ai][1][m][1], x0 = acc[ai][0][m][0] * nr, x1 = acc[ai][0][m][1] * nr;
                        const f32x4 e0 = {__builtin_amdgcn_exp2f(x0[0]), __builtin_amdgcn_exp2f(x0[1]), __builtin_amdgcn_exp2f(x0[2]), __builtin_amdgcn_exp2f(x0[3])};
                        const f32x4 e1 = {__builtin_amdgcn_exp2f(x1[0]), __builtin_amdgcn_exp2f(x1[1]), __builtin_amdgcn_exp2f(x1[2]), __builtin_amdgcn_exp2f(x1[3])};
                        const f32x4 d0 = e0 * ir2 + ir2, d1 = e1 * ir2 + ir2;
                        const f32x4 s0 = {__builtin_amdgcn_rcpf(d0[0]), __builtin_amdgcn_rcpf(d0[1]), __builtin_amdgcn_rcpf(d0[2]), __builtin_amdgcn_rcpf(d0[3])};
                        const f32x4 s1 = {__builtin_amdgcn_rcpf(d1[0]), __builtin_amdgcn_rcpf(d1[1]), __builtin_amdgcn_rcpf(d1[2]), __builtin_amdgcn_rcpf(d1[3])};
                        const f32x4 o0 = p0 * s0, o1 = p1 * s1;
                        u32x4 w; w.x = cvt_pk_bf16(o0[0], o0[1]); w.y = cvt_pk_bf16(o0[2], o0[3]); w.z = cvt_pk_bf16(o1[0], o1[1]); w.w = cvt_pk_bf16(o1[2], o1[3]);
                        *(u32x4*)rowp = w; }
            }
        }
    }
};
template <class Epi, class Sched, bool ALIGN_EPI = false, bool SP2 = false>
__device__ __forceinline__ void gemm_phase(PG8_LAS unsigned char* lds, const Gemm g, const Sched& S, const Epi& E) {
    int tid_ = threadIdx.x; asm volatile("" : "+v"(tid_));
    const int tid = tid_, wid = __builtin_amdgcn_readfirstlane(tid >> 6), lane = tid & 63, wr = wid >> 2, wc = wid & 3, fr = lane & 15, fq = lane >> 4;
    const int K = g.K, nt = K / BK;
    unsigned voffA[2], voffB[2];
#pragma unroll
    for (int i = 0; i < 2; ++i) { int R, C; stage_rc(tid * 16 + i * 8192, R, C); const int Rb = E.perm() ? ((R & ~31) + perm32(R & 31)) : R;
        voffA[i] = (unsigned)(R * K + C) * 2u; voffB[i] = (unsigned)(Rb * K + C) * 2u; }
    const size_t kstep = (size_t)(BK * 2);
    const size_t hstep = (size_t)HALF * K * 2;
    const size_t tstep = 2 * hstep;
    const unsigned ldsw = (unsigned)wid * 1024u;
    const int aoff = lds_byte(wr * 64 + fr, fq * 8), boff = lds_byte(wc * 32 + fr, fq * 8);
#define PG8_SA(b, h) (((b) * 2 + (h)) * HTB)
#define PG8_SB(b, h) ((4 + (b) * 2 + (h)) * HTB)
#define PG8_STAGE(bufoff, gbase, voff) do { _Pragma("unroll") for (int _i = 0; _i < 2; ++_i) \
        __builtin_amdgcn_global_load_lds((const unsigned*)((const char*)(gbase) + (voff)[_i]), (PG8_LAS unsigned*)(lds + (bufoff) + ldsw + _i * 8192), 16, 0, 0); } while (0)
#define PG8_LDA(dst, b, h) do { _Pragma("unroll") for (int m = 0; m < 4; ++m) _Pragma("unroll") for (int k = 0; k < 2; ++k) dst[m][k] = *(const PG8_LAS bf16x8*)(lds + PG8_SA(b, h) + aoff + m * 2048 + k * 1024); } while (0)
#define PG8_LDB(dst, b, h) do { _Pragma("unroll") for (int n = 0; n < 2; ++n) _Pragma("unroll") for (int k = 0; k < 2; ++k) dst[n][k] = *(const PG8_LAS bf16x8*)(lds + PG8_SB(b, h) + boff + n * 2048 + k * 1024); } while (0)
#define PG8_MMA(ai, bj, At, Bt) do { __builtin_amdgcn_s_setprio(1); _Pragma("unroll") for (int m = 0; m < 4; ++m) _Pragma("unroll") for (int n = 0; n < 2; ++n) _Pragma("unroll") for (int k = 0; k < 2; ++k) \
        acc[ai][bj][m][n] = __builtin_amdgcn_mfma_f32_16x16x32_bf16(Bt[n][k], At[m][k], acc[ai][bj][m][n], 0, 0, 0); __builtin_amdgcn_s_setprio(0); } while (0)
#define PG8_WAIT_V(n) asm volatile("s_waitcnt vmcnt(" #n ")" ::: "memory")
#define PG8_WAIT_L(n) asm volatile("s_waitcnt lgkmcnt(" #n ")" ::: "memory")
#define PG8_BAR __builtin_amdgcn_s_barrier()
#define PG8_SCHED __builtin_amdgcn_sched_barrier(0)
    Unit cur, nxt; int ui = 0;
    if (!S.next(0, cur)) return;
    f32x4 acc[2][2][4][2];
#pragma unroll
    for (int a = 0; a < 2; ++a)
#pragma unroll
        for (int b = 0; b < 2; ++b)
#pragma unroll
            for (int m = 0; m < 4; ++m)
#pragma unroll
                for (int n = 0; n < 2; ++n) acc[a][b][m][n] = (f32x4){0.f, 0.f, 0.f, 0.f};
    bf16x8 At[4][2], B0[2][2], B1[2][2];
    const char* cA = (const char*)g.A + (size_t)cur.pm * tstep; const char* cB = (const char*)g.Bt + (size_t)cur.pn * tstep;
    S.a_ready(cur);
    if constexpr (SP2) {
        PG8_STAGE(PG8_SB(0, 0), cB, voffB); PG8_STAGE(PG8_SB(0, 1), cB + hstep, voffB); PG8_STAGE(PG8_SA(0, 0), cA, voffA); PG8_STAGE(PG8_SA(0, 1), cA + hstep, voffA);
        if (wr == 1) PG8_BAR;
        PG8_WAIT_V(2); PG8_BAR;
        PG8_STAGE(PG8_SB(1, 0), cB + kstep, voffB); PG8_STAGE(PG8_SA(1, 0), cA + kstep, voffA); PG8_STAGE(PG8_SB(1, 1), cB + hstep + kstep, voffB);
        PG8_WAIT_V(6); PG8_BAR;
    } else {
        PG8_STAGE(PG8_SB(0, 0), cB, voffB); PG8_STAGE(PG8_SA(0, 0), cA, voffA); PG8_STAGE(PG8_SB(0, 1), cB + hstep, voffB); PG8_STAGE(PG8_SA(0, 1), cA + hstep, voffA);
        if (wr == 1) PG8_BAR;
        PG8_WAIT_V(4); PG8_BAR;
        PG8_STAGE(PG8_SB(1, 0), cB + kstep, voffB); PG8_STAGE(PG8_SA(1, 0), cA + kstep, voffA); PG8_STAGE(PG8_SB(1, 1), cB + hstep + kstep, voffB);
        PG8_WAIT_V(6); PG8_BAR;
    }
    for (;;) {
        const bool has_next = S.next(ui + 1, nxt);
        const char* nA = has_next ? (const char*)g.A + (size_t)nxt.pm * tstep : cA; const char* nB = has_next ? (const char*)g.Bt + (size_t)nxt.pn * tstep : cB;
        for (int t = 0; t < nt; t += 2) {
            const bool last = (t == nt - 2);
            const char* a1 = cA + (size_t)(t + 1) * kstep;
            const char* a2 = last ? nA : cA + (size_t)(t + 2) * kstep; const char* b2 = last ? nB : cB + (size_t)(t + 2) * kstep;
            const char* a3 = a2 + kstep; const char* b3 = b2 + kstep;
            if (last && has_next) S.a_ready(nxt);
            if constexpr (SP2) {
            PG8_LDB(B0, 0, 0); PG8_LDB(B1, 0, 1); PG8_SCHED; PG8_LDA(At, 0, 0); PG8_STAGE(PG8_SA(1, 1), a1 + hstep, voffA);
            PG8_WAIT_V(8); PG8_WAIT_L(0); PG8_BAR; PG8_MMA(0, 0, At, B0); PG8_MMA(0, 1, At, B1); PG8_BAR; PG8_SCHED;
            PG8_LDA(At, 0, 1); PG8_STAGE(PG8_SB(0, 0), b2, voffB); PG8_STAGE(PG8_SB(0, 1), b2 + hstep, voffB); PG8_STAGE(PG8_SA(0, 0), a2, voffA);
            PG8_WAIT_V(8); PG8_WAIT_L(0); PG8_BAR; PG8_MMA(1, 0, At, B0); PG8_MMA(1, 1, At, B1); PG8_BAR; PG8_SCHED;
            PG8_LDB(B0, 1, 0); PG8_LDB(B1, 1, 1); PG8_SCHED; PG8_LDA(At, 1, 0); PG8_STAGE(PG8_SA(0, 1), a2 + hstep, voffA);
            PG8_WAIT_V(8); PG8_WAIT_L(0); PG8_BAR; PG8_MMA(0, 0, At, B0); PG8_MMA(0, 1, At, B1); PG8_BAR; PG8_SCHED;
            PG8_LDA(At, 1, 1); PG8_STAGE(PG8_SB(1, 0), b3, voffB); PG8_STAGE(PG8_SB(1, 1), b3 + hstep, voffB); PG8_STAGE(PG8_SA(1, 0), a3, voffA);
            PG8_WAIT_V(8); PG8_WAIT_L(0); PG8_BAR; PG8_MMA(1, 0, At, B0); PG8_MMA(1, 1, At, B1); PG8_BAR; PG8_SCHED;
            } else {
            PG8_LDB(B0, 0, 0); PG8_SCHED; PG8_LDA(At, 0, 0); PG8_STAGE(PG8_SA(1, 1), a1 + hstep, voffA);
            PG8_WAIT_L(8); PG8_BAR; PG8_WAIT_L(0); PG8_MMA(0, 0, At, B0); PG8_BAR; PG8_SCHED;
            PG8_LDB(B1, 0, 1); PG8_STAGE(PG8_SB(0, 0), b2, voffB);
            PG8_BAR; PG8_WAIT_L(0); PG8_MMA(0, 1, At, B1); PG8_BAR;
            PG8_LDA(At, 0, 1); PG8_STAGE(PG8_SA(0, 0), a2, voffA);
            PG8_BAR; PG8_WAIT_L(0); PG8_MMA(1, 0, At, B0); PG8_BAR; PG8_SCHED;
            PG8_STAGE(PG8_SB(0, 1), b2 + hstep, voffB);
            PG8_WAIT_V(6); PG8_BAR; PG8_MMA(1, 1, At, B1); PG8_BAR;
            PG8_LDB(B0, 1, 0); PG8_SCHED; PG8_LDA(At, 1, 0); PG8_STAGE(PG8_SA(0, 1), a2 + hstep, voffA);
            PG8_WAIT_L(8); PG8_BAR; PG8_WAIT_L(0); PG8_MMA(0, 0, At, B0); PG8_BAR; PG8_SCHED;
            PG8_LDB(B1, 1, 1); PG8_STAGE(PG8_SB(1, 0), b3, voffB);
            PG8_BAR; PG8_WAIT_L(0); PG8_MMA(0, 1, At, B1); PG8_BAR;
            PG8_LDA(At, 1, 1); PG8_STAGE(PG8_SA(1, 0), a3, voffA);
            PG8_BAR; PG8_WAIT_L(0); PG8_MMA(1, 0, At, B0); PG8_BAR; PG8_SCHED;
            PG8_STAGE(PG8_SB(1, 1), b3 + hstep, voffB);
            PG8_WAIT_V(6); PG8_BAR; PG8_MMA(1, 1, At, B1); PG8_BAR;
            }
        }
        if constexpr (ALIGN_EPI) { if (wr == 0) PG8_BAR; }
        if constexpr (!Epi::AFTER_DRAIN) { E(acc, cur, wr, wc, fr, fq); S.done(cur); }
        if (!has_next) break;
#pragma unroll
        for (int a = 0; a < 2; ++a)
#pragma unroll
            for (int b = 0; b < 2; ++b)
#pragma unroll
                for (int m = 0; m < 4; ++m)
#pragma unroll
                    for (int n = 0; n < 2; ++n) acc[a][b][m][n] = (f32x4){0.f, 0.f, 0.f, 0.f};
        cur = nxt; cA = nA; cB = nB; ++ui;
        if constexpr (ALIGN_EPI) { if (wr == 1) PG8_BAR; }
    }
    PG8_WAIT_V(0);
    if constexpr (!ALIGN_EPI) { if (wr == 0) PG8_BAR; }
    PG8_BAR;
    if constexpr (Epi::AFTER_DRAIN) { E.fused(acc, cur, wr, wc, fr, fq, lds, wid, lane); S.done(cur); }
#undef PG8_SA
#undef PG8_SB
#undef PG8_STAGE
#undef PG8_LDA
#undef PG8_LDB
#undef PG8_MMA
#undef PG8_WAIT_V
#undef PG8_WAIT_L
#undef PG8_BAR
#undef PG8_SCHED
}
}
__device__ __forceinline__ bf16* ws_wt(const Params& P, int l, size_t off) { return (bf16*)(P.ws + WS_WT + (size_t)l * WT_STRIDE + off); }
__device__ __forceinline__ bf16* ws_h(const Params& P) { return (bf16*)(P.ws + WS_H); }
__device__ __forceinline__ bf16* ws_proj(const Params& P, int b = 0) { (void)b; return (bf16*)(P.ws + WS_PROJ); }
__device__ __forceinline__ bf16* ws_ff(const Params& P) { return (bf16*)(P.ws + WS_PROJ); }
__device__ __forceinline__ bf16* ws_mixed(const Params& P) { return (bf16*)(P.ws + WS_MIXED); }

__device__ __forceinline__ void transpose_item(const float* W, int ldw, int col0, int ncols, bf16* WT, int ldt, int drow0, int k0, LAS float* scr, int lane, const float* gk = nullptr) {
    const int rr = lane >> 4, c4 = (lane & 15) * 4; f32x4 v[16];
#pragma unroll
    for (int i = 0; i < 16; ++i) v[i] = (c4 < ncols) ? __builtin_nontemporal_load((const f32x4*)(W + (size_t)(k0 + 4 * i + rr) * ldw + col0 + c4)) : (f32x4){0.f, 0.f, 0.f, 0.f};
    if (gk) {
#pragma unroll
        for (int i = 0; i < 16; ++i) v[i] = v[i] * gk[k0 + 4 * i + rr]; }
#pragma unroll
    for (int i = 0; i < 16; ++i) { LAS float* d = scr + (4 * i + rr) * 65 + c4; d[0] = v[i].x; d[1] = v[i].y; d[2] = v[i].z; d[3] = v[i].w; }
    LDS_WAIT();
    const int c8 = lane & 7;
#pragma unroll
    for (int j = 0; j < 8; ++j) { const int n = (lane >> 3) + 8 * j; const LAS float* s = scr + (8 * c8) * 65 + n;
        u32x4 o; o.x = pk2(s[0 * 65], s[1 * 65]); o.y = pk2(s[2 * 65], s[3 * 65]); o.z = pk2(s[4 * 65], s[5 * 65]); o.w = pk2(s[6 * 65], s[7 * 65]);
        if (n < ncols) *(u32x4*)(WT + (size_t)(drow0 + n) * ldt + k0 + 8 * c8) = o; }
    LDS_WAIT();
}
constexpr int CV_IN = 81 * 32, CV_OUT = 32 * 32, CV_GU = 88 * 32, CV_DN = 32 * 88, CV_PW = 16, CV_LAYER = CV_IN + CV_OUT + 3 * CV_GU + CV_PW;
static_assert(CV_GU == CV_DN, "gate/up/down item counts");
__device__ __forceinline__ void ph_convert(const Params& P, const Ctx& C) {
    LAS float* scr = (LAS float*)(C.lds + C.wave * 16640);
    const int gw = C.bid * 8 + C.wave, NGW = C.G * 8;
    for (int it = gw; it < DEPTH * CV_LAYER; it += NGW) {
        const int l = it / CV_LAYER; int r = it % CV_LAYER;
        if (r < CV_IN) { const int nb = r % 81, kb = r / 81; int col0, drow0, nc = 64;
            if (nb < 72) { col0 = 64 * nb; drow0 = 64 * nb;
                if ((unsigned)(nb - 8) < 16u) { const int cb = (nb - 8) & 7; drow0 = 512 + 256 * (cb >> 1) + 128 * ((nb - 8) >> 3) + 64 * (cb & 1); } }
            else if (nb < 80) { col0 = 4624 + 64 * (nb - 72); drow0 = 4608 + 64 * (nb - 72); } else { col0 = 4608; drow0 = NPROJ; nc = 16; }
            transpose_item(P.w_in + (size_t)l * D_MODEL * IN_COLS, IN_COLS, col0, nc, ws_wt(P, l, WT_IN), D_MODEL, drow0, 64 * kb, scr, C.lane, P.norm1_g + l * D_MODEL); continue; }
        r -= CV_IN;
        if (r < CV_OUT) { const int nb = r % 32, kb = r / 32;
            transpose_item(P.w_out + (size_t)l * D_MODEL * D_MODEL, D_MODEL, 64 * nb, 64, ws_wt(P, l, WT_OUT), D_MODEL, 64 * nb, 64 * kb, scr, C.lane); continue; }
        r -= CV_OUT;
        if (r < 2 * CV_GU) { const int up = r >= CV_GU; if (up) r -= CV_GU; const int nb = r % 88, kb = r / 88;
            transpose_item((up ? P.w_up : P.w_gate) + (size_t)l * D_MODEL * DFF, DFF, 64 * nb, 64, ws_wt(P, l, WT_GU), D_MODEL, 256 * (nb >> 1) + 64 * (nb & 1) + (up ? 128 : 0), 64 * kb, scr, C.lane, P.norm2_g + l * D_MODEL); continue; }
        r -= 2 * CV_GU;
        if (r < CV_DN) { const int nb = r % 32, kb = r / 32;
            transpose_item(P.w_down + (size_t)l * DFF * D_MODEL, D_MODEL, 64 * nb, 64, ws_wt(P, l, WT_DN), DFF, 64 * nb, 64 * kb, scr, C.lane); continue; }
        r -= CV_DN;
        { const int g = r >> 2, nb = r & 1, kb = (r >> 1) & 1;
            transpose_item(P.pool_w + (size_t)(l * 4 + g) * 128 * 128, 128, 64 * nb, 64, ws_wt(P, l, WT_PW) + (size_t)g * 128 * 128, 128, 64 * nb, 64 * kb, scr, C.lane); }
    }
}

__device__ __forceinline__ unsigned long long* ws_rss(const Params& P, int which) { return (unsigned long long*)(P.ws + WS_GA) + which * MTOK; }
__device__ __forceinline__ void ph_x0(const float* x, bf16* xb, unsigned long long* rss, const Ctx& C) {
    const int gw = C.bid * 8 + C.wave, NGW = C.G * 8;
    for (int m = gw; m < MTOK; m += NGW) {
        const f32x4* xr = (const f32x4*)(x + (size_t)m * D_MODEL) + C.lane;
        f32x4 v[8]; float s = 0.f; u32x2 w[8];
#pragma unroll
        for (int j = 0; j < 8; ++j) v[j] = xr[64 * j];
#pragma unroll
        for (int j = 0; j < 8; ++j) { w[j].x = pk2(v[j].x, v[j].y); w[j].y = pk2(v[j].z, v[j].w); const float a = bflo(w[j].x), b = bfhi(w[j].x), c = bflo(w[j].y), d = bfhi(w[j].y); s += (a * a + b * b) + (c * c + d * d); }
        s = wave_sum(s);
        if (C.lane == 0) __hip_atomic_store(rss + m, (unsigned long long)(s * 1048576.0f + 0.5f), __ATOMIC_RELAXED, __HIP_MEMORY_SCOPE_AGENT);
        u32x2* o8 = (u32x2*)(xb + (size_t)m * D_MODEL) + C.lane;
#pragma unroll
        for (int j = 0; j < 8; ++j) o8[64 * j] = w[j];
    }
}
__device__ __forceinline__ void zero_rss(unsigned long long* rss, const Ctx& C) { if (C.tid < 64) __hip_atomic_store(rss + SEQ * C.grp + 64 * (4 * (C.rk & 7) + (C.rk >> 3)) + C.tid, 0ull, __ATOMIC_RELAXED, __HIP_MEMORY_SCOPE_AGENT); }

typedef float f32x16 __attribute__((ext_vector_type(16)));
typedef short s16x4 __attribute__((ext_vector_type(4)));
typedef short v4i16_t __attribute__((ext_vector_type(4)));
#define MFMA16(a, b, c) __builtin_amdgcn_mfma_f32_16x16x32_bf16((a), (b), (c), 0, 0, 0)
#define MFMA32(a, b, c) __builtin_amdgcn_mfma_f32_32x32x16_bf16((a), (b), (c), 0, 0, 0)
__device__ __forceinline__ s16x4 lds_tr(const LAS unsigned char* p) { return __builtin_bit_cast(s16x4, __builtin_amdgcn_ds_read_tr16_b64_v4i16((LAS v4i16_t*)p)); }
__device__ __forceinline__ bf16x8 cat8(s16x4 lo, s16x4 hi) { return __builtin_shufflevector(lo, hi, 0, 1, 2, 3, 4, 5, 6, 7); }
typedef __bf16 bf16x2_t __attribute__((ext_vector_type(2)));
__device__ __forceinline__ unsigned cvtpk(float lo, float hi) { const f32x2 v = {lo, hi}; const bf16x2_t b = __builtin_convertvector(v, bf16x2_t); return __builtin_bit_cast(unsigned, b); }
__device__ __forceinline__ float fexp2(float x) { return __builtin_amdgcn_exp2f(x); }
__device__ __forceinline__ float flog2(float x) { return __builtin_amdgcn_logf(x); }
constexpr float LOG2E = 1.4426950408889634f;

constexpr size_t SCR_KF = 16 * MiB, SCR_BCUM = 48 * MiB, SCR_UT = 64 * MiB, SCR_ST = 96 * MiB, SCR_BYTES = 112 * MiB;
static_assert(WS_SCR + SCR_BYTES <= WS_END, "scratch map");
__device__ __forceinline__ bf16* scr_bf(const Params& P, size_t off) { return (bf16*)(P.ws + WS_SCR + off); }
__device__ __forceinline__ float* scr_f32(const Params& P, size_t off) { return (float*)(P.ws + WS_SCR + off); }

__device__ __forceinline__ float log2_sigmoid(float x) { const float z = x * LOG2E; return fminf(z, 0.f) - flog2(1.0f + fexp2(-fabsf(z))); }
__device__ __forceinline__ void unpack8(const u32x4 v, float (&f)[8]) { f[0] = bflo(v.x); f[1] = bfhi(v.x); f[2] = bflo(v.y); f[3] = bfhi(v.y); f[4] = bflo(v.z); f[5] = bfhi(v.z); f[6] = bflo(v.w); f[7] = bfhi(v.w); }

__device__ __forceinline__ void m1_conv(const Params& P, int l, int chunk, const Ctx& C) {
    const bf16* proj = ws_proj(P, C.grp); bf16* mixed = ws_mixed(P); const float* cw = P.conv_w + (size_t)l * 3 * GW;
    const int c8 = (C.tid & 63) * 8, tq = C.tid >> 6, m0 = chunk * 64 + 8 * tq, t0 = m0 & (SEQ - 1);
    u32x4 cc[10], bb[8];
#pragma unroll
    for (int i = 0; i < 10; ++i) { const bool ok = (t0 - 2 + i) >= 0; const size_t row = (size_t)(ok ? m0 - 2 + i : m0);
        cc[i] = *(const u32x4*)(proj + row * PROJ_LD + PC_CC + c8);
        if (!ok) { cc[i] = (u32x4){0u, 0u, 0u, 0u}; } }
#pragma unroll
    for (int i = 0; i < 8; ++i) bb[i] = *(const u32x4*)(proj + (size_t)(m0 + i) * PROJ_LD + PC_CB + c8);
    float w[3][8];
#pragma unroll
    for (int i = 0; i < 3; ++i) { const f32x4 w0 = *(const f32x4*)(cw + i * GW + c8), w1 = *(const f32x4*)(cw + i * GW + c8 + 4); w[i][0] = w0.x; w[i][1] = w0.y; w[i][2] = w0.z; w[i][3] = w0.w; w[i][4] = w1.x; w[i][5] = w1.y; w[i][6] = w1.z; w[i][7] = w1.w; }
    float u[10][8];
#pragma unroll
    for (int i = 0; i < 10; ++i) unpack8(cc[i], u[i]);
#pragma unroll
    for (int i = 0; i < 8; ++i) { float bv[8], y[8]; unpack8(bb[i], bv);
#pragma unroll
        for (int e = 0; e < 8; ++e) y[e] = bv[e] * (w[0][e] * u[i][e] + w[1][e] * u[i + 1][e] + w[2][e] * u[i + 2][e]);
        u32x4 o; o.x = cvtpk(y[0], y[1]); o.y = cvtpk(y[2], y[3]); o.z = cvtpk(y[4], y[5]); o.w = cvtpk(y[6], y[7]);
        *(u32x4*)(mixed + (size_t)(m0 + i) * D_MODEL + MC_CONV + c8) = o; }
}

constexpr int PL_STRIDE = 136;
template <int W> __device__ __forceinline__ void pool_rows(const bf16* up  , int t0  , LAS bf16* dst  ) {
    u32x4 raw[W + 7];
#pragma unroll
    for (int i = 0; i < W + 7; ++i) { const int dt = i - (W - 1); const bool ok = (t0 + dt) >= 0; raw[i] = *(const u32x4*)(up + (ptrdiff_t)(ok ? dt : 0) * PROJ_LD); if (!ok) raw[i] = (u32x4){0u, 0u, 0u, 0u}; }
    float S[8];
#pragma unroll
    for (int e = 0; e < 8; ++e) S[e] = 0.f;
#pragma unroll
    for (int i = 0; i < W - 1; ++i) { float f[8]; unpack8(raw[i], f);
#pragma unroll
        for (int e = 0; e < 8; ++e) S[e] += f[e]; }
#pragma unroll
    for (int tk = 0; tk < 8; ++tk) { float f[8], g[8], y[8]; unpack8(raw[W - 1 + tk], f); unpack8(raw[tk], g);
        const int t = t0 + tk; const float inv = 1.0f / (float)((t + 1 < W) ? t + 1 : W);
#pragma unroll
        for (int e = 0; e < 8; ++e) { S[e] += f[e]; y[e] = S[e] * inv - f[e]; S[e] -= g[e]; }
        u32x4 o; o.x = cvtpk(y[0], y[1]); o.y = cvtpk(y[2], y[3]); o.z = cvtpk(y[4], y[5]); o.w = cvtpk(y[6], y[7]);
        *(LAS u32x4*)(dst + tk * PL_STRIDE) = o; }
}
__device__ __forceinline__ void m1_pool(const Params& P, int l, int chunk, const Ctx& C) {
    const bf16* proj = ws_proj(P, C.grp); bf16* mixed = ws_mixed(P);
    LAS bf16* PLs = (LAS bf16*)C.lds;
    const int m0 = chunk * 64, t0 = m0 & (SEQ - 1);
    __syncthreads();
    bf16x8 paf[4][4]; f32x4 psc[4];
    { const int g = C.wave >> 1, nh = C.wave & 1, li = C.lane & 15, lg = C.lane >> 4; const bf16* pw = ws_wt(P, l, WT_PW) + (size_t)g * 128 * 128;
#pragma unroll
      for (int d4 = 0; d4 < 4; ++d4) { const int dt = 4 * nh + d4;
#pragma unroll
          for (int ks = 0; ks < 4; ++ks) paf[d4][ks] = *(const bf16x8*)(pw + (size_t)(16 * dt + li) * 128 + 32 * ks + 8 * lg);
          psc[d4] = *(const f32x4*)(P.pool_scale + l * GW + g * 128 + 16 * dt + 4 * lg); } }
    { const int g = C.wave >> 1, cg = C.lane & 15, tq = (C.wave & 1) * 4 + (C.lane >> 4), ch = g * 128 + cg * 8;
      const bf16* up = proj + (size_t)(m0 + 8 * tq) * PROJ_LD + PC_PU + ch; LAS bf16* dst = PLs + (g * 64 + 8 * tq) * PL_STRIDE + cg * 8;
      if (g == 0) pool_rows<2>(up, t0 + 8 * tq, dst); else if (g == 1) pool_rows<4>(up, t0 + 8 * tq, dst); else if (g == 2) pool_rows<8>(up, t0 + 8 * tq, dst); else pool_rows<16>(up, t0 + 8 * tq, dst); }
    __syncthreads();
    { const int g = C.wave >> 1, nh = C.wave & 1, li = C.lane & 15, lg = C.lane >> 4;
#pragma unroll
      for (int d4 = 0; d4 < 4; ++d4) { const int dt = 4 * nh + d4;
#pragma unroll
          for (int tt = 0; tt < 4; ++tt) { f32x4 acc = {0.f, 0.f, 0.f, 0.f};
#pragma unroll
              for (int ks = 0; ks < 4; ++ks) { const bf16x8 bfr = *(const LAS bf16x8*)(PLs + (g * 64 + 16 * tt + li) * PL_STRIDE + 32 * ks + 8 * lg); acc = MFMA16(paf[d4][ks], bfr, acc); }
              u32x2 o; o.x = cvtpk(acc[0] * psc[d4][0], acc[1] * psc[d4][1]); o.y = cvtpk(acc[2] * psc[d4][2], acc[3] * psc[d4][3]);
              *(u32x2*)(mixed + (size_t)(m0 + 16 * tt + li) * D_MODEL + MC_POOL + g * 128 + 16 * dt + 4 * lg) = o; } } }
}


constexpr float SB_QSCALE = 0.08838834764831845f * LOG2E;
typedef __bf16 bf16x2v __attribute__((ext_vector_type(2)));
__device__ __forceinline__ float dot2sq(unsigned w, float acc) { const bf16x2v v = __builtin_bit_cast(bf16x2v, w); return __builtin_amdgcn_fdot2_f32_bf16(v, v, acc, false); }
constexpr int SBV_STRIDE = 320;
constexpr int SBV_TILE = 32 * SBV_STRIDE, SB_RK_OFF = 8 * SBV_TILE;
__device__ __forceinline__ void m2_sb(const Params& P, int l, const Ctx& C) {
    bf16* mixed = ws_mixed(P);
    const int lane = C.lane, q = lane & 31, hi = lane >> 5;
    __syncthreads();
    {
        const int bh = 4 * C.grp + (C.rk >> 3), j8 = C.rk & 7, strip = (C.wave < 4) ? 4 * j8 + C.wave : 63 - 4 * j8 - (C.wave - 4);
        const int b = bh >> 2, h = bh & 3;
        const bf16* pb = ws_proj(P, C.grp) + (size_t)b * SEQ * PROJ_LD;
        const bf16* kbase = scr_bf(P, SCR_KF) + (size_t)bh * 64 * 4096 + lane * 8;
        const bf16* vcol = pb + (size_t)(lane >> 4) * PROJ_LD + PC_SV + h * 128 + 8 * (lane & 15);
        LAS unsigned char* vt = C.lds + C.wave * SBV_TILE; LAS float* rkl = (LAS float*)(C.lds + SB_RK_OFF + C.wave * 128);
        LAS unsigned char* vw = vt + (lane >> 4) * SBV_STRIDE + (lane & 15) * 16;
        const LAS unsigned char* vr = vt + (4 * hi + ((lane >> 2) & 3)) * SBV_STRIDE + (16 * ((lane >> 4) & 1) + 4 * (lane & 3)) * 2;
        bf16x8 qf[8], kf[8];
        { const bf16* qp = pb + (size_t)(strip * 32 + q) * PROJ_LD + PC_SQ + h * 128 + 8 * hi; u32x4 xq[8];
#pragma unroll
          for (int s = 0; s < 8; ++s) xq[s] = *(const u32x4*)(qp + 16 * s);
#pragma unroll
          for (int s = 0; s < 8; ++s) kf[s] = *(const bf16x8*)(kbase + (size_t)strip * 4096 + s * 512);
          float ss = 0.f;
#pragma unroll
          for (int s = 0; s < 8; ++s) { ss = dot2sq(xq[s].x, ss); ss = dot2sq(xq[s].y, ss); ss = dot2sq(xq[s].z, ss); ss = dot2sq(xq[s].w, ss); }
          ss += __shfl_xor(ss, 32);
          const float rq = SB_QSCALE / sqrtf(ss * (1.0f / 128.f) + RMS_EPS); const float* qg = P.sb_q_g + l * 128 + 8 * hi; const float* kg = P.sb_k_g + l * 128 + 8 * hi;
#pragma unroll
          for (int s = 0; s < 8; ++s) { float f[8]; unpack8(xq[s], f); const f32x4 g0 = *(const f32x4*)(qg + 16 * s) * *(const f32x4*)(kg + 16 * s) * rq, g1 = *(const f32x4*)(qg + 16 * s + 4) * *(const f32x4*)(kg + 16 * s + 4) * rq;
              u32x4 o; o.x = cvtpk(f[0] * g0.x, f[1] * g0.y); o.y = cvtpk(f[2] * g0.z, f[3] * g0.w); o.z = cvtpk(f[4] * g1.x, f[5] * g1.y); o.w = cvtpk(f[6] * g1.z, f[7] * g1.w);
              qf[s] = __builtin_bit_cast(bf16x8, o); } }
        f32x16 O[4];
#pragma unroll
        for (int mt = 0; mt < 4; ++mt)
#pragma unroll
            for (int r = 0; r < 16; ++r) O[mt][r] = 0.f;
        float carry = 0.f;
        for (int kt = strip; kt >= 0; --kt) {
            u32x4 xv[8];
#pragma unroll
            for (int i = 0; i < 8; ++i) xv[i] = *(const u32x4*)(vcol + (size_t)(kt * 32 + 4 * i) * PROJ_LD);
            __builtin_amdgcn_sched_barrier(0);
            f32x16 S;
#pragma unroll
            for (int r = 0; r < 16; ++r) S[r] = 0.f;
#pragma unroll
            for (int s = 0; s < 8; ++s) S = MFMA32(kf[s], qf[s], S);
            { float ss = 0.f;
#pragma unroll
              for (int s = 0; s < 8; ++s) { const u32x4 w = __builtin_bit_cast(u32x4, kf[s]); ss = dot2sq(w.x, ss); ss = dot2sq(w.y, ss); ss = dot2sq(w.z, ss); ss = dot2sq(w.w, ss); }
              ss += __shfl_xor(ss, 32);
              rkl[q] = 1.0f / sqrtf(ss * (1.0f / 128.f) + RMS_EPS); }
            __builtin_amdgcn_sched_barrier(0);
            { const bf16* kn = kbase + (size_t)(kt > 0 ? kt - 1 : 0) * 4096;
#pragma unroll
              for (int s = 0; s < 8; ++s) kf[s] = *(const bf16x8*)(kn + s * 512); }
            __builtin_amdgcn_sched_barrier(0);
#pragma unroll
            for (int c = 0; c < 4; ++c) { const f32x4 rk4 = *(const LAS f32x4*)(rkl + 8 * c + 4 * hi); S[4 * c] *= rk4.x; S[4 * c + 1] *= rk4.y; S[4 * c + 2] *= rk4.z; S[4 * c + 3] *= rk4.w; }
            const bool diag = (kt == strip);
            float ls[16], lr[16];
#pragma unroll
            for (int r = 0; r < 16; ++r) { const float z = S[r]; const int key = (r & 3) + 8 * (r >> 2) + 4 * hi; const bool valid = !diag || key < q;
                const float e = fexp2(-fabsf(z)), l2 = flog2(1.0f + e); ls[r] = fminf(z, 0.f) - l2; lr[r] = valid ? ls[r] - z : 0.f; if (!valid) ls[r] = -1e30f; }
            float gs[4], og[4];
#pragma unroll
            for (int c = 0; c < 4; ++c) { gs[c] = (lr[4 * c] + lr[4 * c + 1]) + (lr[4 * c + 2] + lr[4 * c + 3]); og[c] = __shfl_xor(gs[c], 32); }
            float R[4]; R[3] = 0.f; R[2] = gs[3] + og[3]; R[1] = R[2] + (gs[2] + og[2]); R[0] = R[1] + (gs[1] + og[1]);
            const float total = R[0] + (gs[0] + og[0]);
            unsigned pk[8];
#pragma unroll
            for (int c = 0; c < 4; ++c) { const float T = R[c] + (hi == 0 ? og[c] : 0.f) + carry;
                const float s3 = T, s2 = s3 + lr[4 * c + 3], s1 = s2 + lr[4 * c + 2], s0 = s1 + lr[4 * c + 1];
                const float a0 = fexp2(ls[4 * c] + s0), a1 = fexp2(ls[4 * c + 1] + s1), a2 = fexp2(ls[4 * c + 2] + s2), a3 = fexp2(ls[4 * c + 3] + s3);
                pk[2 * c] = cvtpk(a0, a1); pk[2 * c + 1] = cvtpk(a2, a3); }
            carry += total;
            bf16x8 p0, p1; { u32x4 w0 = {pk[0], pk[1], pk[2], pk[3]}, w1 = {pk[4], pk[5], pk[6], pk[7]}; p0 = __builtin_bit_cast(bf16x8, w0); p1 = __builtin_bit_cast(bf16x8, w1); }
            __builtin_amdgcn_sched_barrier(0);
#pragma unroll
            for (int i = 0; i < 8; ++i) *(LAS u32x4*)(vw + i * 4 * SBV_STRIDE) = xv[i];
#pragma unroll
            for (int mt = 0; mt < 4; ++mt) {
                const bf16x8 v0 = cat8(lds_tr(vr + 64 * mt), lds_tr(vr + 8 * SBV_STRIDE + 64 * mt));
                const bf16x8 v1 = cat8(lds_tr(vr + 16 * SBV_STRIDE + 64 * mt), lds_tr(vr + 24 * SBV_STRIDE + 64 * mt));
                O[mt] = MFMA32(v0, p0, O[mt]); O[mt] = MFMA32(v1, p1, O[mt]); }
            if (__all(carry < -135.0f)) break;
        }
        bf16* orow = mixed + ((size_t)b * SEQ + strip * 32 + q) * D_MODEL + MC_SB + h * 128;
#pragma unroll
        for (int mt = 0; mt < 4; ++mt)
#pragma unroll
            for (int c = 0; c < 4; c += 2) {
                const unsigned a0 = cvtpk(O[mt][4 * c], O[mt][4 * c + 1]), a1 = cvtpk(O[mt][4 * c + 2], O[mt][4 * c + 3]);
                const unsigned b0 = cvtpk(O[mt][4 * c + 4], O[mt][4 * c + 5]), b1 = cvtpk(O[mt][4 * c + 6], O[mt][4 * c + 7]);
                const auto s0 = __builtin_amdgcn_permlane32_swap(a0, b0, false, false), s1 = __builtin_amdgcn_permlane32_swap(a1, b1, false, false);
                u32x4 o; o.x = s0[0]; o.y = s1[0]; o.z = s0[1]; o.w = s1[1];
                *(u32x4*)(orow + 32 * mt + 8 * (c + hi)) = o; }
    }
}
constexpr int GK_STRIDE = 72, GV_STRIDE = 136;
__device__ __forceinline__ void m1_gla_a(const Params& P, int l, int chunk, const Ctx& C) {
    const bf16* proj = ws_proj(P, C.grp); const bf16* hbuf = ws_h(P); const bf16* wa = ws_wt(P, l, WT_IN) + (size_t)NPROJ * D_MODEL;
    float* BCUM = scr_f32(P, SCR_BCUM); bf16* UT = scr_bf(P, SCR_UT);
    LAS float* Bc = (LAS float*)C.lds;
    LAS float* GAp = (LAS float*)(C.lds + 65536);
    LAS float* GAs = (LAS float*)(C.lds + 65536 + 32768);
    LAS float* AW = GAs + 1024;
    LAS float* AB = AW + 4096;
    LAS unsigned char* TK = C.lds + 65536;
    LAS unsigned char* TV = TK + 2 * 64 * GK_STRIDE * 2;
    const int m0 = chunk * 64, b = m0 >> 11, cc = (m0 & (SEQ - 1)) >> 6, tid = C.tid, lane = C.lane, li = lane & 15, lg = lane >> 4;
    u32x4 kq[2], vq[4];
#define GLA_A_ISSUE(hp_) do { _Pragma("unroll") for (int j = 0; j < 2; ++j) { const int i = tid + 512 * j, hs = i >> 9, t = (i >> 3) & 63, k8 = (i & 7) * 8, h = 2 * (hp_) + hs; \
            kq[j] = *(const u32x4*)(proj + (size_t)(m0 + t) * PROJ_LD + PC_GK + h * 64 + k8); } \
        _Pragma("unroll") for (int j = 0; j < 4; ++j) { const int i = tid + 512 * j, hs = i >> 10, t = (i >> 4) & 63, v8 = (i & 15) * 8, h = 2 * (hp_) + hs; \
            vq[j] = *(const u32x4*)(proj + (size_t)(m0 + t) * PROJ_LD + PC_GV + h * 128 + v8); } } while (0)
    GLA_A_ISSUE(0);
    __syncthreads();
    for (int i = tid; i < 4096; i += 512) AW[i] = P.gla_a_w[(size_t)l * 4096 + i];
    if (tid < 256) AB[tid] = P.gla_a_b[l * 256 + tid];
    { f32x4 acc[4];
#pragma unroll
      for (int mt = 0; mt < 4; ++mt) acc[mt] = (f32x4){0.f, 0.f, 0.f, 0.f};
#pragma unroll 8
      for (int kk = 0; kk < 8; ++kk) { const int ks = 8 * C.wave + kk;
          const bf16x8 bfr = *(const bf16x8*)(wa + (size_t)li * D_MODEL + 32 * ks + 8 * lg);
#pragma unroll
          for (int mt = 0; mt < 4; ++mt) { const bf16x8 afr = *(const bf16x8*)(hbuf + (size_t)(m0 + 16 * mt + li) * D_MODEL + 32 * ks + 8 * lg); acc[mt] = MFMA16(afr, bfr, acc[mt]); } }
#pragma unroll
      for (int mt = 0; mt < 4; ++mt)
#pragma unroll
          for (int r = 0; r < 4; ++r) GAp[(C.wave * 64 + 16 * mt + 4 * lg + r) * 16 + li] = acc[mt][r]; }
    __syncthreads();
    for (int o = tid; o < 1024; o += 512) { float s = 0.f;
#pragma unroll
        for (int w = 0; w < 8; ++w) s += GAp[w * 1024 + o];
        GAs[o] = s * (1.0f / sqrtf((float)__hip_atomic_load(ws_rss(P, 0) + m0 + (o >> 4), __ATOMIC_RELAXED, __HIP_MEMORY_SCOPE_AGENT) * (1.0f / (2048.0f * 1048576.0f)) + RMS_EPS)); }
    __syncthreads();
    { const int col = tid & 255, half = tid >> 8; float aw[16];
#pragma unroll
      for (int j = 0; j < 16; ++j) aw[j] = AW[j * 256 + col];
      const float ab = AB[col]; float run = 0.f;
      for (int t = 32 * half; t < 32 * half + 32; ++t) { float lg2 = ab;
#pragma unroll
          for (int j = 0; j < 16; ++j) lg2 += GAs[t * 16 + j] * aw[j];
          run += log2_sigmoid(lg2) * (1.0f / 16.0f); Bc[t * 256 + col] = run; } }
    __syncthreads();
    { const int col = tid & 255, half = tid >> 8;
      if (half) { const float tot = Bc[31 * 256 + col]; for (int t = 32; t < 64; ++t) Bc[t * 256 + col] += tot; } }
    __syncthreads();
    for (int i = tid; i < 64 * 64; i += 512) { const int t = i >> 6, c4 = (i & 63) * 4; const LAS float* s = Bc + t * 256 + c4; *(f32x4*)(BCUM + (size_t)(m0 + t) * 256 + c4) = (f32x4){s[0], s[1], s[2], s[3]}; }
#pragma unroll
    for (int hp = 0; hp < 2; ++hp) {
        __syncthreads();
#pragma unroll
        for (int j = 0; j < 2; ++j) { const int i = tid + 512 * j, hs = i >> 9, t = (i >> 3) & 63, k8 = (i & 7) * 8, h = 2 * hp + hs;
            const u32x4 k4 = kq[j]; const LAS float* bb = Bc + t * 256 + h * 64 + k8;
            u32x4 o; o.x = cvtpk(bflo(k4.x) * fexp2(-bb[0]), bfhi(k4.x) * fexp2(-bb[1])); o.y = cvtpk(bflo(k4.y) * fexp2(-bb[2]), bfhi(k4.y) * fexp2(-bb[3]));
            o.z = cvtpk(bflo(k4.z) * fexp2(-bb[4]), bfhi(k4.z) * fexp2(-bb[5])); o.w = cvtpk(bflo(k4.w) * fexp2(-bb[6]), bfhi(k4.w) * fexp2(-bb[7]));
            *(LAS u32x4*)(TK + ((hs * 64 + t) * GK_STRIDE + k8) * 2) = o; }
#pragma unroll
        for (int j = 0; j < 4; ++j) { const int i = tid + 512 * j, hs = i >> 10, t = (i >> 4) & 63, v8 = (i & 15) * 8;
            *(LAS u32x4*)(TV + ((hs * 64 + t) * GV_STRIDE + v8) * 2) = vq[j]; }
        if (hp == 0) GLA_A_ISSUE(1);
        __syncthreads();
        { const int hs = C.wave >> 2, qr = C.wave & 3, h = 2 * hp + hs, bh = b * 4 + h, q4 = li >> 2, p4 = li & 3;
          const LAS unsigned char* tk = TK + hs * 64 * GK_STRIDE * 2; const LAS unsigned char* tv = TV + hs * 64 * GV_STRIDE * 2;
          f32x4 acc[2][4];
#pragma unroll
          for (int a = 0; a < 2; ++a)
#pragma unroll
              for (int n = 0; n < 4; ++n) acc[a][n] = (f32x4){0.f, 0.f, 0.f, 0.f};
#pragma unroll
          for (int ks = 0; ks < 2; ++ks) { const int trow = 32 * ks + 8 * lg + q4;
              bf16x8 kfr[4];
#pragma unroll
              for (int n = 0; n < 4; ++n) kfr[n] = cat8(lds_tr(tk + (trow * GK_STRIDE + 16 * n + 4 * p4) * 2), lds_tr(tk + ((trow + 4) * GK_STRIDE + 16 * n + 4 * p4) * 2));
#pragma unroll
              for (int a = 0; a < 2; ++a) { const int v0 = 16 * (2 * qr + a);
                  const bf16x8 vfr = cat8(lds_tr(tv + (trow * GV_STRIDE + v0 + 4 * p4) * 2), lds_tr(tv + ((trow + 4) * GV_STRIDE + v0 + 4 * p4) * 2));
#pragma unroll
                  for (int n = 0; n < 4; ++n) acc[a][n] = MFMA16(kfr[n], vfr, acc[a][n]); } }
          bf16* ut = UT + ((size_t)bh * 32 + cc) * 8192;
#pragma unroll
          for (int a = 0; a < 2; ++a)
#pragma unroll
              for (int n = 0; n < 4; n += 2) {
                  const unsigned a0 = cvtpk(acc[a][n][0], acc[a][n][1]), a1 = cvtpk(acc[a][n][2], acc[a][n][3]), b0 = cvtpk(acc[a][n + 1][0], acc[a][n + 1][1]), b1 = cvtpk(acc[a][n + 1][2], acc[a][n + 1][3]);
                  const auto s0 = __builtin_amdgcn_permlane16_swap(a0, b0, false, false), s1 = __builtin_amdgcn_permlane16_swap(a1, b1, false, false);
                  u32x4 o; o.x = s0[0]; o.y = s1[0]; o.z = s0[1]; o.w = s1[1];
                  *(u32x4*)(ut + (16 * (2 * qr + a) + li) * 64 + 16 * (n + (lg & 1)) + 4 * (lg & 2)) = o; } }
    }
}
#undef GLA_A_ISSUE

__device__ __forceinline__ void m2_gla_scan(const Params& P, const Ctx& C) {
    const float* BCUM = scr_f32(P, SCR_BCUM); const bf16* UT = scr_bf(P, SCR_UT); bf16* ST = scr_bf(P, SCR_ST);
    { const int e = C.grp * 16384 + C.rk * 512 + C.tid;
        const int bh = e >> 12, v = (e >> 5) & 127, k2 = (e & 31) * 2, b = bh >> 2, h = bh & 3;
        const size_t uo0 = ((size_t)bh * 32 * 128 + v) * 64 + k2; const float* bl0 = BCUM + ((size_t)b * SEQ + 63) * 256 + h * 64 + k2;
        unsigned u[32]; f32x2 bl[32];
#pragma unroll
        for (int c = 0; c < 32; ++c) { u[c] = *(const unsigned*)(UT + uo0 + (size_t)c * 8192); bl[c] = *(const f32x2*)(bl0 + (size_t)c * 64 * 256); }
        float s0 = 0.f, s1 = 0.f;
#pragma unroll
        for (int c = 0; c < 32; ++c) { *(unsigned*)(ST + uo0 + (size_t)c * 8192) = cvtpk(s0, s1); s0 = fexp2(bl[c].x) * (s0 + bflo(u[c])); s1 = fexp2(bl[c].y) * (s1 + bfhi(u[c])); }
    }
}

__device__ __forceinline__ void m3_gla_c(const Params& P, int l, const Ctx& C) {
    const bf16* proj = ws_proj(P, C.grp); bf16* mixed = ws_mixed(P); const float* BCUM = scr_f32(P, SCR_BCUM); const bf16* ST = scr_bf(P, SCR_ST);
    const float* ng = P.gla_norm_g + l * 128;
    LAS unsigned char* TQ = C.lds;
    LAS unsigned char* TK = TQ + 2 * 64 * GK_STRIDE * 2;
    LAS unsigned char* TV = TK + 2 * 64 * GK_STRIDE * 2;
    const int tid = C.tid, lane = C.lane, li = lane & 15, lg = lane >> 4, q4 = li >> 2, p4 = li & 3;
    const int chunk = 32 * C.grp + 4 * (C.rk & 7) + (C.rk >> 3),
              m0 = chunk * 64, b = m0 >> 11, cc = (m0 & (SEQ - 1)) >> 6;
    const int hs = C.wave >> 2, tt = C.wave & 3;
#pragma unroll 1
    for (int hp = 0; hp < 2; ++hp) {
        const int h = 2 * hp + hs, bh = b * 4 + h;
        u32x4 sq[2], sk[2], sv[4]; f32x4 sb0[2], sb1[2];
#pragma unroll
        for (int j = 0; j < 2; ++j) { const int i = tid + 512 * j, hh = 2 * hp + (i >> 9), t = (i >> 3) & 63, k8 = (i & 7) * 8;
            sq[j] = *(const u32x4*)(proj + (size_t)(m0 + t) * PROJ_LD + PC_GQ + hh * 64 + k8); sk[j] = *(const u32x4*)(proj + (size_t)(m0 + t) * PROJ_LD + PC_GK + hh * 64 + k8);
            const float* bp = BCUM + (size_t)(m0 + t) * 256 + hh * 64 + k8; sb0[j] = *(const f32x4*)bp; sb1[j] = *(const f32x4*)(bp + 4); }
#pragma unroll
        for (int j = 0; j < 4; ++j) { const int i = tid + 512 * j, hh = 2 * hp + (i >> 10), t = (i >> 4) & 63, v8 = (i & 15) * 8;
            sv[j] = *(const u32x4*)(proj + (size_t)(m0 + t) * PROJ_LD + PC_GV + hh * 128 + v8); }
        const bf16* st_base = ST + ((size_t)bh * 32 + cc) * 8192; const size_t mrow = (size_t)(m0 + 16 * tt + li);
        bf16x8 stf[8][2]; u32x2 r2[8];
#pragma unroll
        for (int mv = 0; mv < 8; ++mv) {
#pragma unroll
            for (int ks = 0; ks < 2; ++ks) stf[mv][ks] = *(const bf16x8*)(st_base + (size_t)(16 * mv + li) * 64 + 32 * ks + 8 * lg);
            r2[mv] = *(const u32x2*)(proj + mrow * PROJ_LD + PC_GR + h * 128 + 16 * mv + 4 * lg); }
        __syncthreads();
#pragma unroll
        for (int j = 0; j < 2; ++j) { const int i = tid + 512 * j, hsl = i >> 9, t = (i >> 3) & 63, k8 = (i & 7) * 8;
            const float bb[8] = {sb0[j].x, sb0[j].y, sb0[j].z, sb0[j].w, sb1[j].x, sb1[j].y, sb1[j].z, sb1[j].w}; float fq[8], fk[8]; unpack8(sq[j], fq); unpack8(sk[j], fk);
#pragma unroll
            for (int e = 0; e < 8; ++e) { fq[e] *= fexp2(bb[e]) * 0.125f; fk[e] *= fexp2(-bb[e]); }
            u32x4 oq, ok; oq.x = cvtpk(fq[0], fq[1]); oq.y = cvtpk(fq[2], fq[3]); oq.z = cvtpk(fq[4], fq[5]); oq.w = cvtpk(fq[6], fq[7]);
            ok.x = cvtpk(fk[0], fk[1]); ok.y = cvtpk(fk[2], fk[3]); ok.z = cvtpk(fk[4], fk[5]); ok.w = cvtpk(fk[6], fk[7]);
            *(LAS u32x4*)(TQ + ((hsl * 64 + t) * GK_STRIDE + k8) * 2) = oq; *(LAS u32x4*)(TK + ((hsl * 64 + t) * GK_STRIDE + k8) * 2) = ok; }
#pragma unroll
        for (int j = 0; j < 4; ++j) { const int i = tid + 512 * j, hsl = i >> 10, t = (i >> 4) & 63, v8 = (i & 15) * 8; *(LAS u32x4*)(TV + ((hsl * 64 + t) * GV_STRIDE + v8) * 2) = sv[j]; }
        __syncthreads();
        const LAS unsigned char* tq = TQ + hs * 64 * GK_STRIDE * 2; const LAS unsigned char* tk = TK + hs * 64 * GK_STRIDE * 2; const LAS unsigned char* tv = TV + hs * 64 * GV_STRIDE * 2;
        bf16x8 bq[2];
#pragma unroll
        for (int ks = 0; ks < 2; ++ks) bq[ks] = *(const LAS bf16x8*)(tq + ((16 * tt + li) * GK_STRIDE + 32 * ks + 8 * lg) * 2);
        bf16x8 bp[2];
#pragma unroll
        for (int kb = 0; kb < 2; ++kb) { unsigned w[4] = {0u, 0u, 0u, 0u};
            if (2 * kb <= tt) {
#pragma unroll
                for (int x = 0; x < 2; ++x) { const int st = 2 * kb + x; f32x4 a = {0.f, 0.f, 0.f, 0.f};
                    if (st <= tt) {
#pragma unroll
                        for (int ks = 0; ks < 2; ++ks) { const bf16x8 ak = *(const LAS bf16x8*)(tk + ((16 * st + li) * GK_STRIDE + 32 * ks + 8 * lg) * 2); a = MFMA16(ak, bq[ks], a); }
                        if (st == tt) {
#pragma unroll
                            for (int r = 0; r < 4; ++r) if (4 * lg + r > li) a[r] = 0.f; } }
                    w[2 * x] = cvtpk(a[0], a[1]); w[2 * x + 1] = cvtpk(a[2], a[3]); } }
            u32x4 wv = {w[0], w[1], w[2], w[3]}; bp[kb] = __builtin_bit_cast(bf16x8, wv); }
        f32x4 acc[8];
#pragma unroll
        for (int mv = 0; mv < 8; ++mv) { acc[mv] = (f32x4){0.f, 0.f, 0.f, 0.f};
#pragma unroll
            for (int ks = 0; ks < 2; ++ks) acc[mv] = MFMA16(stf[mv][ks], bq[ks], acc[mv]);
#pragma unroll
            for (int kb = 0; kb < 2; ++kb) { if (2 * kb <= tt) { const int r0 = 32 * kb + 4 * lg + q4;
                const bf16x8 av = cat8(lds_tr(tv + (r0 * GV_STRIDE + 16 * mv + 4 * p4) * 2), lds_tr(tv + ((r0 + 16) * GV_STRIDE + 16 * mv + 4 * p4) * 2));
                acc[mv] = MFMA16(av, bp[kb], acc[mv]); } } }
        float ss = 0.f;
#pragma unroll
        for (int mv = 0; mv < 8; ++mv) ss += (acc[mv][0] * acc[mv][0] + acc[mv][1] * acc[mv][1]) + (acc[mv][2] * acc[mv][2] + acc[mv][3] * acc[mv][3]);
        ss += __shfl_xor(ss, 16); ss += __shfl_xor(ss, 32);
        const float rstd = 1.0f / sqrtf(ss * (1.0f / 128.f) + RMS_EPS);
        u32x2 ov[8];
#pragma unroll
        for (int mv = 0; mv < 8; ++mv) { const int v4 = 16 * mv + 4 * lg; const f32x4 g4 = *(const f32x4*)(ng + v4);
            const float rr[4] = {bflo(r2[mv].x), bfhi(r2[mv].x), bflo(r2[mv].y), bfhi(r2[mv].y)}; float y[4];
#pragma unroll
            for (int r = 0; r < 4; ++r) y[r] = acc[mv][r] * rstd * g4[r] * rr[r] * __builtin_amdgcn_rcpf(1.0f + fexp2(-LOG2E * rr[r]));
            ov[mv].x = cvtpk(y[0], y[1]); ov[mv].y = cvtpk(y[2], y[3]); }
#pragma unroll
        for (int mv = 0; mv < 8; mv += 2) {
            const auto s0 = __builtin_amdgcn_permlane16_swap(ov[mv].x, ov[mv + 1].x, false, false), s1 = __builtin_amdgcn_permlane16_swap(ov[mv].y, ov[mv + 1].y, false, false);
            u32x4 o; o.x = s0[0]; o.y = s1[0]; o.z = s0[1]; o.w = s1[1];
            *(u32x4*)(mixed + mrow * D_MODEL + MC_GLA + h * 128 + 16 * (mv + (lg & 1)) + 4 * (lg & 2)) = o; }
    }
}
constexpr int RS_LDS_OFF = 131072;
__device__ __forceinline__ void ph_gemm(const Params& P, int l, int s, const Ctx& C) {
    pg8::Gemm g; pg8::EpiAny E;
    const LAS float* rsl = (const LAS float*)(C.lds + RS_LDS_OFF);
    if (s == 0)      { g = pg8::Gemm{ws_h(P), ws_wt(P, l, WT_IN), MTOK, NPROJ, D_MODEL};      E = pg8::EpiAny{0, ws_proj(P, C.grp), nullptr, nullptr, PROJ_LD, ws_rss(P, 0), nullptr, rsl, -1}; }
    else if (s == 1) { g = pg8::Gemm{ws_mixed(P), ws_wt(P, l, WT_OUT), MTOK, D_MODEL, D_MODEL}; E = pg8::EpiAny{1, nullptr, ws_h(P), nullptr, D_MODEL, nullptr, ws_rss(P, 1), rsl, -1}; }
    else if (s == 2) { g = pg8::Gemm{ws_h(P), ws_wt(P, l, WT_GU), MTOK, NGU, D_MODEL};        E = pg8::EpiAny{2, ws_ff(P), nullptr, nullptr, DFF, ws_rss(P, 1), nullptr, rsl, -1}; }
    else             { g = pg8::Gemm{ws_ff(P), ws_wt(P, l, WT_DN), MTOK, D_MODEL, DFF};       E = pg8::EpiAny{1, nullptr, ws_h(P), (l + 1 < DEPTH) ? nullptr : P.out, D_MODEL, nullptr, ws_rss(P, 0), rsl, -1}; }
    pg8::GroupOrder S{g.N / 256, C.grp, C.rk};
    if ((s & 1) == 0) { pg8::Unit u0; if (S.next(0, u0)) { E.pm0 = u0.pm;
        if (C.tid < 256) ((LAS float*)(C.lds + RS_LDS_OFF))[C.tid] = 1.0f / sqrtf((float)__hip_atomic_load(E.rss_in + u0.pm * 256 + C.tid, __ATOMIC_RELAXED, __HIP_MEMORY_SCOPE_AGENT) * (1.0f / (2048.0f * 1048576.0f)) + RMS_EPS); }
        __syncthreads(); }
    pg8::gemm_phase<pg8::EpiAny, pg8::GroupOrder, true, true>(C.lds, g, S, E);
}

#define XB_TMO      128
#define XB_XCNT(j)  (256  + 64 * (j))
#define XB_XSUB(j)  (1280 + 64 * (j))
#define XB_XGEN(j)  (2304 + 64 * (j))
#define XB_TOP      3328
#define XB_TOPGEN   3392
#define XCD_BAR_WORDS 3456
#define XB_SPIN_CAP (1u << 18)

__device__ __forceinline__ unsigned xb_ld(unsigned* p)              { return __hip_atomic_load(p, __ATOMIC_RELAXED, __HIP_MEMORY_SCOPE_AGENT); }
__device__ __forceinline__ unsigned xb_add(unsigned* p, unsigned v) { return __hip_atomic_fetch_add(p, v, __ATOMIC_RELAXED, __HIP_MEMORY_SCOPE_AGENT); }
__device__ __forceinline__ unsigned xb_xcc_id() { return (unsigned)__builtin_amdgcn_s_getreg((3 << 11) | 20) & 0xFu; }
#define XB_SPIN(cond, bar) do { unsigned _sp = 0; while (cond) { __builtin_amdgcn_s_sleep(1); \
    if ((++_sp & 255u) == 0u) { if (xb_ld(&(bar)[XB_TMO])) break; if (_sp > XB_SPIN_CAP) { atomicAdd(&(bar)[XB_TMO], 1u); break; } } } } while (0)

struct XcdBarrier {
    unsigned* bar; unsigned x;
    volatile LAS unsigned* st;
};

__device__ __forceinline__ XcdBarrier xcd_barrier_post(unsigned* bar, volatile LAS unsigned* st) {
    XcdBarrier b; b.bar = bar; b.x = xb_xcc_id(); b.st = st;
    if (threadIdx.x == 0) (void)xb_add(&bar[XB_XCNT(b.x)], 1u);
    return b;
}
__device__ __forceinline__ void xcd_barrier_complete(unsigned* bar, unsigned x, unsigned& nloc, unsigned& nx) {
    const unsigned G = gridDim.x * gridDim.y * gridDim.z;
    unsigned sum, cnt, mine, sp = 0u;
    for (;;) {
        sum = 0u; cnt = 0u; mine = 0u;
#pragma unroll
        for (unsigned j = 0; j < 16; ++j) { const unsigned c = xb_ld(&bar[XB_XCNT(j)]); sum += c; cnt += (c > 0u) ? 1u : 0u; mine = (j == x) ? c : mine; }
        if (sum == G) break;
        __builtin_amdgcn_s_sleep(1);
        if ((++sp & 255u) == 0u) { if (xb_ld(&bar[XB_TMO])) break; if (sp > XB_SPIN_CAP) { atomicAdd(&bar[XB_TMO], 1u); break; } }
    }
    nloc = mine > 0u ? mine : 1u; nx = cnt > 0u ? cnt : 1u;
}

__device__ __forceinline__ void xcd_barrier(const XcdBarrier& b) {
    asm volatile("s_waitcnt vmcnt(0)" ::: "memory");
    __syncthreads();
    if (threadIdx.x == 0) {
        unsigned* bar = b.bar;
        __builtin_amdgcn_s_waitcnt(0);
        unsigned nloc = b.st[0], nx = b.st[1];
        if (nloc == 0u) { xcd_barrier_complete(bar, b.x, nloc, nx); b.st[0] = nloc; b.st[1] = nx; }
        const unsigned old = xb_add(&bar[XB_XSUB(b.x)], 1u);
        const unsigned gen = old / nloc;
        if (old + 1u == (gen + 1u) * nloc) {
            __builtin_amdgcn_fence(__ATOMIC_RELEASE, "agent");
            asm volatile("s_waitcnt vmcnt(0)" ::: "memory");
            const unsigned og = xb_add(&bar[XB_TOP], 1u);
            const unsigned tg = og / nx;
            if (og + 1u == (tg + 1u) * nx) xb_add(&bar[XB_TOPGEN], 1u);
            else XB_SPIN(xb_ld(&bar[XB_TOPGEN]) == tg, bar);
            __builtin_amdgcn_fence(__ATOMIC_ACQUIRE, "agent");
            xb_add(&bar[XB_XGEN(b.x)], 1u);
            asm volatile("s_waitcnt vmcnt(0)" ::: "memory");
        } else {
            XB_SPIN(xb_ld(&bar[XB_XGEN(b.x)]) == gen, bar);
            __builtin_amdgcn_fence(__ATOMIC_ACQUIRE, "agent");
            asm volatile("s_waitcnt vmcnt(0)" ::: "memory");
        }
    }
    __syncthreads();
}


__device__ __forceinline__ void xcd_barrier_complete_n(unsigned* bar, unsigned x, unsigned G, unsigned& nloc, unsigned& nx) {
    unsigned sum, cnt, mine, sp = 0u;
    for (;;) {
        sum = 0u; cnt = 0u; mine = 0u;
#pragma unroll
        for (unsigned j = 0; j < 16; ++j) { const unsigned c = xb_ld(&bar[XB_XCNT(j)]); sum += c; cnt += (c > 0u) ? 1u : 0u; mine = (j == x) ? c : mine; }
        if (sum == G) break;
        __builtin_amdgcn_s_sleep(1);
        if ((++sp & 255u) == 0u) { if (xb_ld(&bar[XB_TMO])) break; if (sp > XB_SPIN_CAP) { atomicAdd(&bar[XB_TMO], 1u); break; } }
    }
    nloc = mine > 0u ? mine : 1u; nx = cnt > 0u ? cnt : 1u;
}

__device__ __forceinline__ void xcd_barrier_n(const XcdBarrier& b, unsigned G) {
    asm volatile("s_waitcnt vmcnt(0)" ::: "memory");
    __syncthreads();
    if (threadIdx.x == 0) {
        unsigned* bar = b.bar;
        __builtin_amdgcn_s_waitcnt(0);
        unsigned nloc = b.st[0], nx = b.st[1];
        if (nloc == 0u) { xcd_barrier_complete_n(bar, b.x, G, nloc, nx); b.st[0] = nloc; b.st[1] = nx; }
        const unsigned old = xb_add(&bar[XB_XSUB(b.x)], 1u);
        const unsigned gen = old / nloc;
        if (old + 1u == (gen + 1u) * nloc) {
            __builtin_amdgcn_fence(__ATOMIC_RELEASE, "agent");
            asm volatile("s_waitcnt vmcnt(0)" ::: "memory");
            const unsigned og = xb_add(&bar[XB_TOP], 1u);
            const unsigned tg = og / nx;
            if (og + 1u == (tg + 1u) * nx) xb_add(&bar[XB_TOPGEN], 1u);
            else XB_SPIN(xb_ld(&bar[XB_TOPGEN]) == tg, bar);
            __builtin_amdgcn_fence(__ATOMIC_ACQUIRE, "agent");
            xb_add(&bar[XB_XGEN(b.x)], 1u);
            asm volatile("s_waitcnt vmcnt(0)" ::: "memory");
        } else {
            XB_SPIN(xb_ld(&bar[XB_XGEN(b.x)]) == gen, bar);
            __builtin_amdgcn_fence(__ATOMIC_ACQUIRE, "agent");
            asm volatile("s_waitcnt vmcnt(0)" ::: "memory");
        }
    }
    __syncthreads();
}


__device__ __forceinline__ void xcd_arrive_n(const XcdBarrier& b, unsigned G, volatile LAS unsigned* sp) {
    asm volatile("s_waitcnt vmcnt(0)" ::: "memory");
    __syncthreads();
    if (threadIdx.x == 0) {
        unsigned* bar = b.bar;
        __builtin_amdgcn_s_waitcnt(0);
        unsigned nloc = b.st[0], nx = b.st[1];
        if (nloc == 0u) { xcd_barrier_complete_n(bar, b.x, G, nloc, nx); b.st[0] = nloc; b.st[1] = nx; }
        const unsigned old = xb_add(&bar[XB_XSUB(b.x)], 1u);
        const unsigned gen = old / nloc;
        unsigned role = 0u, tg = 0u;
        if (old + 1u == (gen + 1u) * nloc) {
            __builtin_amdgcn_fence(__ATOMIC_RELEASE, "agent");
            asm volatile("s_waitcnt vmcnt(0)" ::: "memory");
            const unsigned og = xb_add(&bar[XB_TOP], 1u);
            tg = og / nx;
            if (og + 1u == (tg + 1u) * nx) { xb_add(&bar[XB_TOPGEN], 1u); xb_add(&bar[XB_XGEN(b.x)], 1u); role = 2u; }
            else role = 1u;
        }
        sp[0] = role; sp[1] = gen; sp[2] = tg;
    }
}
__device__ __forceinline__ void xcd_wait_n(const XcdBarrier& b, volatile LAS unsigned* sp) {
    if (threadIdx.x == 0) {
        unsigned* bar = b.bar; const unsigned role = sp[0], gen = sp[1], tg = sp[2];
        if (role == 1u) { XB_SPIN(xb_ld(&bar[XB_TOPGEN]) == tg, bar); xb_add(&bar[XB_XGEN(b.x)], 1u); }
        else if (role == 0u) XB_SPIN(xb_ld(&bar[XB_XGEN(b.x)]) == gen, bar);
        __builtin_amdgcn_fence(__ATOMIC_ACQUIRE, "agent");
        asm volatile("s_waitcnt vmcnt(0)" ::: "memory");
    }
    __syncthreads();
}


constexpr int LDS_BYTES = 147456;
constexpr int MISC_OFF = LDS_BYTES - 256;
constexpr int CW_BAR = 4096;
#ifndef SPAN_SEL
#define SPAN_SEL 0
#endif
enum { SP_CONVERT = 0, SP_NORM1, SP_GEMM_IN, SP_M1, SP_M2, SP_M3, SP_GEMM_OUT, SP_NORM2, SP_GEMM_GU, SP_GEMM_DN, SP_M1A, SP_M1B, SP_M1C, SP_M1D, SP_M2A };
__global__ void __launch_bounds__(512, 2) mk_fwd(Params P) {
    extern __shared__ __attribute__((aligned(16))) unsigned char lds[];
    Ctx C; C.lds = (LAS unsigned char*)lds; C.tid = threadIdx.x; C.lane = C.tid & 63; C.wave = __builtin_amdgcn_readfirstlane(C.tid >> 6); C.bid = blockIdx.x; C.G = gridDim.x; C.grp = C.bid & 7; C.rk = C.bid >> 3;
    volatile LAS unsigned* MISC = (volatile LAS unsigned*)(C.lds + MISC_OFF);
    if (C.tid < 64) MISC[C.tid] = 0u;
    __syncthreads();
    { unsigned* cb = (unsigned*)(P.ws + WS_CTL) + CW_BAR;
      (void)xcd_barrier_post(cb, MISC); (void)xcd_barrier_post(cb + (1 + C.grp) * XCD_BAR_WORDS, MISC + 2); (void)xcd_barrier_post(cb + (9 + 8 * C.grp + (C.rk & 7)) * XCD_BAR_WORDS, MISC + 4); }
#define MK_BAR(region, stoff, nmemb) do { XcdBarrier b_; int rg_ = (region); asm volatile("" : "+s"(rg_)); b_.bar = (unsigned*)(P.ws + WS_CTL) + CW_BAR + rg_ * XCD_BAR_WORDS; \
        b_.x = (unsigned)__builtin_amdgcn_readfirstlane((int)xb_xcc_id()); b_.st = MISC + (stoff); xcd_barrier_n(b_, (nmemb)); } while (0)
#define GRID_BAR()  MK_BAR(0, 0, (unsigned)C.G)
#define MK_SPLIT(region, stoff, call) do { XcdBarrier b_; int rg_ = (region); asm volatile("" : "+s"(rg_)); b_.bar = (unsigned*)(P.ws + WS_CTL) + CW_BAR + rg_ * XCD_BAR_WORDS; \
        b_.x = (unsigned)__builtin_amdgcn_readfirstlane((int)xb_xcc_id()); b_.st = MISC + (stoff); call; } while (0)
#define GROUP_ARRIVE() MK_SPLIT(1 + C.grp, 2, xcd_arrive_n(b_, 32u, MISC + 8))
#define GROUP_WAIT()   MK_SPLIT(1 + C.grp, 2, xcd_wait_n(b_, MISC + 8))
#define GROUP_BAR() MK_BAR(1 + C.grp, 2, 32u)
#define PANEL_BAR() MK_BAR(9 + 8 * C.grp + (C.rk & 7), 4, 4u)
#if SPAN_SEL
    volatile LAS unsigned long long* SPW = (volatile LAS unsigned long long*)(C.lds + MISC_OFF + 64);
    if (C.tid == 0) { SPW[0] = __builtin_amdgcn_s_memrealtime(); SPW[1] = 0ull; }
#define SPAN(id) do { if (C.tid == 0) { const unsigned long long n_ = __builtin_amdgcn_s_memrealtime(); if ((SPAN_SEL >> (id)) & 1) SPW[1] = SPW[1] + (n_ - SPW[0]); SPW[0] = n_; } } while (0)
#else
#define SPAN(id) do { } while (0)
#endif
#define FRESH(Cn) Ctx Cn = C; { int t_ = C.tid; asm volatile("" : "+v"(t_)); Cn.tid = t_; Cn.lane = t_ & 63; }

    { FRESH(C1); ph_convert(P, C1); }
    { FRESH(C1); ph_x0(P.x, ws_h(P), ws_rss(P, 0), C1); }
    GRID_BAR(); SPAN(SP_CONVERT);
#pragma unroll 1
    for (int l = 0; l < DEPTH; ++l) {
#pragma unroll 1
        for (int s = 0; s < 4; ++s) {
            if (s == 1) {
                { FRESH(C1); zero_rss(ws_rss(P, 1), C1); }
#if SPAN_SEL
#define SUBSPAN(id) do { VM_WAIT(); __syncthreads(); SPAN(id); } while (0)
#else
#define SUBSPAN(id) do { } while (0)
#endif
                SUBSPAN(SP_NORM1);
                { FRESH(C1); m1_gla_a(P, l, 32 * C.grp + C.rk, C1); }
                GROUP_ARRIVE();
                { FRESH(C1); m2_sb(P, l, C1); }
                GROUP_WAIT(); SPAN(SP_M1);
                { FRESH(C1); m2_gla_scan(P, C1); }
                GROUP_ARRIVE();
                { FRESH(C1); m1_conv(P, l, 32 * C.grp + 4 * (C.rk & 7) + (C.rk >> 3), C1); }
                { FRESH(C1); m1_pool(P, l, 32 * C.grp + 4 * (C.rk & 7) + (C.rk >> 3), C1); }
                GROUP_WAIT(); SPAN(SP_M2);
                { FRESH(C1); zero_rss(ws_rss(P, 0), C1); }
                { FRESH(C1); m3_gla_c(P, l, C1); }
                PANEL_BAR(); SPAN(SP_M3);
            }
            { FRESH(C1); ph_gemm(P, l, s, C1); }
            if (s == 0) GROUP_BAR();
            else if (l + 1 < DEPTH || s != 3) PANEL_BAR();
            SPAN(s == 0 ? SP_GEMM_IN : s == 1 ? SP_GEMM_OUT : s == 2 ? SP_GEMM_GU : SP_GEMM_DN);
        }
    }
#if SPAN_SEL
    if (C.tid == 0) { const unsigned long long t0 = __builtin_amdgcn_s_memrealtime(), w = SPW[1]; while (__builtin_amdgcn_s_memrealtime() - t0 < w) __builtin_amdgcn_s_sleep(32); }
#endif
}

extern "C" void kernel_launch(void* const* d_in, const int* in_sizes, int n_in, void* d_out, int out_size, void* d_ws, size_t ws_size, hipStream_t stream) {
    static int grid = 0;
    if (grid == 0) {
        if (n_in != 16 || in_sizes[0] != MTOK * D_MODEL || out_size != MTOK * D_MODEL || ws_size < WS_END) {
            fprintf(stderr, "kernel_launch: unexpected shapes / workspace: n_in %d in0 %d out %d ws %zu (need %zu); nothing launched\n", n_in, n_in > 0 ? in_sizes[0] : -1, out_size, ws_size, (size_t)WS_END); grid = -1; return; }
        int dev = 0, cus = 0, per_cu = 0;
        if (hipGetDevice(&dev) != hipSuccess || hipDeviceGetAttribute(&cus, hipDeviceAttributeMultiprocessorCount, dev) != hipSuccess) { fprintf(stderr, "kernel_launch: device query failed\n"); grid = -1; return; }
        if (hipFuncSetAttribute((const void*)mk_fwd, hipFuncAttributeMaxDynamicSharedMemorySize, LDS_BYTES) != hipSuccess) { fprintf(stderr, "kernel_launch: hipFuncSetAttribute failed\n"); grid = -1; return; }
        if (hipOccupancyMaxActiveBlocksPerMultiprocessor(&per_cu, (const void*)mk_fwd, 512, LDS_BYTES) != hipSuccess || per_cu < 1) { fprintf(stderr, "kernel_launch: occupancy query says %d blocks per CU\n", per_cu); (void)hipGetLastError(); }
        grid = cus;
        if (grid != 256) { fprintf(stderr, "kernel_launch: built for 256 CUs (8 groups of 32 workgroups), device has %d; nothing launched\n", cus); grid = -1; return; }
    }
    if (grid < 0) return;
    if (hipMemsetAsync((char*)d_ws + WS_CTL, 0, CTL_BYTES, stream) != hipSuccess) { fprintf(stderr, "kernel_launch: memset failed\n"); return; }
    Params P{};
    P.x = (const float*)d_in[0]; P.norm1_g = (const float*)d_in[1]; P.w_in = (const float*)d_in[2]; P.conv_w = (const float*)d_in[3]; P.sb_q_g = (const float*)d_in[4]; P.sb_k_g = (const float*)d_in[5];
    P.gla_a_w = (const float*)d_in[6]; P.gla_a_b = (const float*)d_in[7]; P.gla_norm_g = (const float*)d_in[8]; P.pool_w = (const float*)d_in[9]; P.pool_scale = (const float*)d_in[10];
    P.w_out = (const float*)d_in[11]; P.norm2_g = (const float*)d_in[12]; P.w_gate = (const float*)d_in[13]; P.w_up = (const float*)d_in[14]; P.w_down = (const float*)d_in[15];
    P.out = (float*)d_out; P.ws = (unsigned char*)d_ws;
    hipLaunchKernelGGL(mk_fwd, dim3(grid), dim3(512), LDS_BYTES, stream, P);
    const hipError_t le = hipPeekAtLastError();
    if (le != hipSuccess) fprintf(stderr, "kernel_launch: launch failed: %s\n", hipGetErrorName(le));
}
```

```cpp
#include <hip/hip_runtime.h>
#include <cstdio>
#include <cstdint>

#define LAS __attribute__((address_space(3)))
typedef unsigned short bf16;
typedef float f32x4 __attribute__((ext_vector_type(4)));
typedef float f32x2 __attribute__((ext_vector_type(2)));
typedef unsigned u32x4 __attribute__((ext_vector_type(4)));
typedef unsigned u32x2 __attribute__((ext_vector_type(2)));
typedef short bf16x8 __attribute__((ext_vector_type(8)));

constexpr int D_MODEL = 2048, BATCH = 8, SEQ = 2048, DEPTH = 4, MTOK = BATCH * SEQ;
constexpr int GW = 512, IN_COLS = 5136, NPROJ = 5120, DFF = 5632, NGU = 2 * DFF;
constexpr float RMS_EPS = 1e-6f;
constexpr int PROJ_LD = DFF;
constexpr int PC_CB = 0, PC_CC = 512, PC_CH = 1024, PC_SQ = 1536, PC_SK = 2048, PC_SV = 2560, PC_GQ = 3072, PC_GK = 3328, PC_GV = 3584, PC_GR = 4096, PC_PU = 4608;
constexpr int MC_CONV = 0, MC_SB = 512, MC_GLA = 1024, MC_POOL = 1536;

constexpr size_t MiB = 1u << 20;
constexpr size_t WS_CTL = 0, CTL_BYTES = 1 * MiB;
constexpr size_t WS_WT = 1 * MiB;
constexpr size_t WT_IN = 0, WT_OUT = 21 * MiB, WT_GU = 29 * MiB, WT_DN = 73 * MiB, WT_PW = 95 * MiB, WT_STRIDE = 96 * MiB;
static_assert((size_t)(NPROJ + 16) * D_MODEL * 2 <= WT_OUT && (size_t)NGU * D_MODEL * 2 == 44 * MiB && (size_t)D_MODEL * DFF * 2 == 22 * MiB, "weight map");
constexpr size_t WS_H = WS_WT + DEPTH * WT_STRIDE;
constexpr size_t WS_PROJ = WS_H + 64 * MiB;
constexpr size_t WS_MIXED = WS_PROJ + 176 * MiB;
constexpr size_t WS_GA = WS_MIXED + 64 * MiB;
constexpr size_t WS_SCR = WS_GA + 1 * MiB;
constexpr size_t WS_END = WS_SCR + 112 * MiB;
constexpr long long KF_DELTA = ((long long)(WS_SCR + 16 * MiB) - (long long)WS_PROJ) / 2;

struct Params {
    const float* x; const float* norm1_g; const float* w_in; const float* conv_w; const float* sb_q_g; const float* sb_k_g;
    const float* gla_a_w; const float* gla_a_b; const float* gla_norm_g; const float* pool_w; const float* pool_scale;
    const float* w_out; const float* norm2_g; const float* w_gate; const float* w_up; const float* w_down;
    float* out; unsigned char* ws;
};

#define LDS_WAIT() asm volatile("s_waitcnt lgkmcnt(0)" ::: "memory")
#define VM_WAIT() asm volatile("s_waitcnt vmcnt(0)" ::: "memory")
__device__ __forceinline__ float bf2f(unsigned b) { return __uint_as_float(b << 16); }
__device__ __forceinline__ float bflo(unsigned w) { return __uint_as_float(w << 16); }
__device__ __forceinline__ float bfhi(unsigned w) { return __uint_as_float(w & 0xffff0000u); }
__device__ __forceinline__ unsigned f2bf(float f) { unsigned u = __float_as_uint(f); return (u + 0x7fffu + ((u >> 16) & 1u)) >> 16; }
__device__ __forceinline__ unsigned pk2(float lo, float hi) { return f2bf(lo) | (f2bf(hi) << 16); }
__device__ __forceinline__ float wave_sum(float v) {
#pragma unroll
    for (int o = 1; o < 64; o <<= 1) v += __shfl_xor(v, o);
    return v;
}

struct Ctx { LAS unsigned char* lds; int tid, lane, wave, bid, G, grp, rk; };
namespace pg8 {
#define PG8_LAS __attribute__((address_space(3)))
typedef unsigned short bf16_t;
typedef short bf16x8 __attribute__((ext_vector_type(8)));
typedef float f32x4 __attribute__((ext_vector_type(4)));
typedef unsigned u32x4 __attribute__((ext_vector_type(4)));
constexpr int BM = 256, BK = 64, HALF = 128, HTB = HALF * BK * 2  , STAGE_BYTES = 8 * HTB, NXCD = 8, WGM = 8;

__host__ __device__ __forceinline__ int lds_byte(int r, int c) { const int st = (r >> 4) * 2 + (c >> 5), rr = r & 15, cc = c & 31, ob = rr * 64 + cc * 2; return st * 1024 + (ob ^ (((ob >> 9) & 1) << 5)); }
__host__ __device__ __forceinline__ void stage_rc(int b, int& R, int& C) { const int st = b / 1024, sb = b % 1024, swz = sb ^ (((sb >> 9) & 1) << 5); R = (st >> 1) * 16 + swz / 64; C = (st & 1) * 32 + (swz % 64) / 2; }
__host__ __device__ __forceinline__ int perm32(int rho) { const int n = rho >> 4, i = rho & 15; return 8 * (i >> 2) + 4 * n + (i & 3); }

struct Unit { int pm, pn; };
struct Gemm { const bf16_t* A; const bf16_t* Bt; int M, N, K; };

struct StaticOrder {
    int nM, nN, nwg, G, c;
    __host__ __device__ void init(int M, int N, int G_, int c_) { nM = M / BM; nN = N / BM; nwg = nM * nN; G = G_; c = c_; }
    __host__ __device__ bool next(int i, Unit& u) const {
        const long L = (long)i * G + c; if (L >= nwg) return false;
        int wgid = (int)L; { const int q = nwg / NXCD, r = nwg % NXCD, xcd = wgid % NXCD, off = wgid / NXCD; wgid = (xcd < r ? xcd * (q + 1) : r * (q + 1) + (xcd - r) * q) + off; }
        const int nig = WGM * nN, gid = wgid / nig, fm = gid * WGM, gsz = (nM - fm) < WGM ? (nM - fm) : WGM;
        u.pm = fm + ((wgid % nig) % gsz); u.pn = (wgid % nig) / gsz; return true;
    }
    __device__ __forceinline__ void a_ready(const Unit&) const {}
    __device__ __forceinline__ void done(const Unit&) const {}
};

struct GroupOrder {
    int nN, grp, rk;
    __host__ __device__ bool next(int i, Unit& u) const { const int L = i * 32 + rk; if (L >= 8 * nN) return false; u.pm = 8 * grp + (L & 7); u.pn = L >> 3; return true; }
    __device__ __forceinline__ void a_ready(const Unit&) const {}
    __device__ __forceinline__ void done(const Unit&) const {}
};

__device__ __forceinline__ unsigned cvt_pk_bf16(float lo, float hi) { unsigned r; asm volatile("v_cvt_pk_bf16_f32 %0, %1, %2" : "=v"(r) : "v"(lo), "v"(hi)); return r; }

__device__ __forceinline__ float silu_mul(float g, float u) { return g * u * __builtin_amdgcn_rcpf(1.0f + __builtin_amdgcn_exp2f(-1.4426950408889634f * g)); }
struct EpiAny {
    static constexpr bool AFTER_DRAIN = false;
    int mode; bf16_t* O; bf16_t* XB; float* out; int ldc; const unsigned long long* rss_in; unsigned long long* rss_out; const PG8_LAS float* rs_lds; int pm0;
    __device__ __forceinline__ bool perm() const { return true; }
    __device__ __forceinline__ void operator()(const f32x4 (&acc)[2][2][4][2], const Unit& u, int wr, int wc, int fr, int fq) const {
        int pm_ = u.pm; asm volatile("" : "+s"(pm_));
        const int row0 = pm_ * BM + wr * 64 + fr;
        if (mode == 1) {
            const int col0 = u.pn * BM + wc * 32 + 8 * fq;
            float ssr[2][4];
#pragma unroll
            for (int ai = 0; ai < 2; ++ai)
#pragma unroll
                for (int m = 0; m < 4; ++m) { const int row = row0 + ai * HALF + m * 16; const size_t off = (size_t)row * ldc + col0; float ss = 0.f;
#pragma unroll
                    for (int bj = 0; bj < 2; ++bj) { const u32x4 xb = *(const u32x4*)(XB + off + bj * HALF);
                        const f32x4 b0 = {__uint_as_float(xb.x << 16), __uint_as_float(xb.x & 0xffff0000u), __uint_as_float(xb.y << 16), __uint_as_float(xb.y & 0xffff0000u)};
                        const f32x4 b1 = {__uint_as_float(xb.z << 16), __uint_as_float(xb.z & 0xffff0000u), __uint_as_float(xb.w << 16), __uint_as_float(xb.w & 0xffff0000u)};
                        const f32x4 x0 = b0 + acc[ai][bj][m][0], x1 = b1 + acc[ai][bj][m][1];
                        if (out) { *(f32x4*)(out + off + bj * HALF) = x0; *(f32x4*)(out + off + bj * HALF + 4) = x1; }
                        else { u32x4 w; w.x = cvt_pk_bf16(x0[0], x0[1]); w.y = cvt_pk_bf16(x0[2], x0[3]); w.z = cvt_pk_bf16(x1[0], x1[1]); w.w = cvt_pk_bf16(x1[2], x1[3]);
                            *(u32x4*)(XB + off + bj * HALF) = w;
                            const float r0 = __uint_as_float(w.x << 16), r1 = __uint_as_float(w.x & 0xffff0000u), r2 = __uint_as_float(w.y << 16), r3 = __uint_as_float(w.y & 0xffff0000u);
                            const float r4 = __uint_as_float(w.z << 16), r5 = __uint_as_float(w.z & 0xffff0000u), r6 = __uint_as_float(w.w << 16), r7 = __uint_as_float(w.w & 0xffff0000u);
                            ss += (r0 * r0 + r1 * r1) + (r2 * r2 + r3 * r3) + (r4 * r4 + r5 * r5) + (r6 * r6 + r7 * r7); } }
                    if (!out) { ss += __shfl_xor(ss, 16); ss += __shfl_xor(ss, 32); }
                    ssr[ai][m] = ss;
                    asm volatile("" ::: "memory"); }
            if (!out) {
#pragma unroll
                for (int ai = 0; ai < 2; ++ai) { const float sv = fq == 0 ? ssr[ai][0] : fq == 1 ? ssr[ai][1] : fq == 2 ? ssr[ai][2] : ssr[ai][3];
                    __hip_atomic_fetch_add(rss_out + row0 + ai * HALF + fq * 16, (unsigned long long)(sv * 1048576.0f + 0.5f), __ATOMIC_RELAXED, __HIP_MEMORY_SCOPE_AGENT); } }
        } else {
            float rs[2][4];
            if (pm_ == pm0) {
#pragma unroll
                for (int ai = 0; ai < 2; ++ai)
#pragma unroll
                    for (int m = 0; m < 4; ++m) rs[ai][m] = rs_lds[wr * 64 + fr + ai * HALF + m * 16];
            } else {
#pragma unroll
                for (int ai = 0; ai < 2; ++ai)
#pragma unroll
                    for (int m = 0; m < 4; ++m) rs[ai][m] = 1.0f / sqrtf((float)__hip_atomic_load(rss_in + row0 + ai * HALF + m * 16, __ATOMIC_RELAXED, __HIP_MEMORY_SCOPE_AGENT) * (1.0f / (2048.0f * 1048576.0f)) + 1e-6f);
            }
            const bool prod = mode == 0 && (unsigned)(u.pn - 2) < 4u;
            if (mode == 0 && !prod) {
                const int col0 = u.pn * BM + wc * 32 + 8 * fq;
                const bool kfr = (unsigned)(u.pn - 8) < 2u;
                const int colk = (u.pn - 8) * 524288 + (2 * wc + (fq >> 1)) * 512 + (fq & 1) * 256; const int bjs = kfr ? 262144 : HALF;
#pragma unroll
                for (int ai = 0; ai < 2; ++ai)
#pragma unroll
                    for (int m = 0; m < 4; ++m) { const int row = row0 + ai * HALF + m * 16; const float r = rs[ai][m];
                        bf16_t* rowp = O + (kfr ? (size_t)KF_DELTA + (size_t)(row >> 11) * 1048576 + (size_t)(((row >> 5) & 63) * 4096 + (row & 31) * 8 + colk) : (size_t)row * ldc + col0);
#pragma unroll
                        for (int bj = 0; bj < 2; ++bj) { const f32x4 v0 = acc[ai][bj][m][0] * r, v1 = acc[ai][bj][m][1] * r;
                            u32x4 w; w.x = cvt_pk_bf16(v0[0], v0[1]); w.y = cvt_pk_bf16(v0[2], v0[3]); w.z = cvt_pk_bf16(v1[0], v1[1]); w.w = cvt_pk_bf16(v1[2], v1[3]);
                            *(u32x4*)(rowp + bj * bjs) = w; } }
            } else if (prod) {
                const int col0 = PC_CC + (u.pn - 2) * HALF + wc * 32 + 8 * fq;
#pragma unroll
                for (int ai = 0; ai < 2; ++ai)
#pragma unroll
                    for (int m = 0; m < 4; ++m) { bf16_t* rowp = O + (size_t)(row0 + ai * HALF + m * 16) * ldc + col0; const float r2 = rs[ai][m] * rs[ai][m];
                        const f32x4 p0 = acc[ai][0][m][0] * acc[ai][1][m][0] * r2, p1 = acc[ai][0][m][1] * acc[ai][1][m][1] * r2;
                        u32x4 w; w.x = cvt_pk_bf16(p0[0], p0[1]); w.y = cvt_pk_bf16(p0[2], p0[3]); w.z = cvt_pk_bf16(p1[0], p1[1]); w.w = cvt_pk_bf16(p1[2], p1[3]);
                        *(u32x4*)rowp = w; }
            } else {
                const int col0 = u.pn * HALF + wc * 32 + 8 * fq;
#pragma unroll
                for (int ai = 0; ai < 2; ++ai)
#pragma unroll
                    for (int m = 0; m < 4; ++m) { bf16_t* rowp = O + (size_t)(row0 + ai * HALF + m * 16) * ldc + col0; const float r = rs[ai][m];
                        const float nr = -1.4426950408889634f * r, ir2 = __builtin_amdgcn_rcpf(r * r);
                        const f32x4 p0 = acc[ai][0][m][0] * acc[ai][1][m][0], p1 = acc[ai][0][m][1] * acc[ai][1][m][1], x0 = acc[ai][0][m][0] * nr, x1 = acc[ai][0][m][1] * nr;
                        const f32x4 e0 = {__builtin_amdgcn_exp2f(x0[0]), __builtin_amdgcn_exp2f(x0[1]), __builtin_amdgcn_exp2f(x0[2]), __builtin_amdgcn_exp2f(x0[3])};
                        const f32x4 e1 = {__builtin_amdgcn_exp2f(x1[0]), __builtin_amdgcn_exp2f(x1[1]), __builtin_amdgcn_exp2f(x1[2]), __builtin_amdgcn_exp2f(x1[3])};
                        const f32x4 d0 = e0 * ir2 + ir2, d1 = e1 * ir2 + ir2;
                        const f32x4 s0 = {__builtin_amdgcn_rcpf(d0[0]), __builtin_amdgcn_rcpf(d0[1]), __builtin_amdgcn_rcpf(d0[2]), __builtin_amdgcn_rcpf(d0[3])};
                        const f32x4 s1 = {__builtin_amdgcn_rcpf(d1[0]), __builtin_amdgcn_rcpf(d1[1]), __builtin_amdgcn_rcpf(d1[2]), __builtin_amdgcn_rcpf(d1[3])};
                        const f32x4 o0 = p0 * s0, o1 = p1 * s1;
                        u32x4 w; w.x = cvt_pk_bf16(o0[0], o0[1]); w.y = cvt_pk_bf16(o0[2], o0[3]); w.z = cvt_pk_bf16(o1[0], o1[1]); w.w = cvt_pk_bf16(o1[2], o1[3]);
                        *(u32x4*)rowp = w; }
            }
        }
    }
};
template <class Epi, class Sched, bool ALIGN_EPI = false, bool SP2 = false>
__device__ __forceinline__ void gemm_phase(PG8_LAS unsigned char* lds, const Gemm g, const Sched& S, const Epi& E) {
    int tid_ = threadIdx.x; asm volatile("" : "+v"(tid_));
    const int tid = tid_, wid = __builtin_amdgcn_readfirstlane(tid >> 6), lane = tid & 63, wr = wid >> 2, wc = wid & 3, fr = lane & 15, fq = lane >> 4;
    const int K = g.K, nt = K / BK;
    unsigned voffA[2], voffB[2];
#pragma unroll
    for (int i = 0; i < 2; ++i) { int R, C; stage_rc(tid * 16 + i * 8192, R, C); const int Rb = E.perm() ? ((R & ~31) + perm32(R & 31)) : R;
        voffA[i] = (unsigned)(R * K + C) * 2u; voffB[i] = (unsigned)(Rb * K + C) * 2u; }
    const size_t kstep = (size_t)(BK * 2);
    const size_t hstep = (size_t)HALF * K * 2;
    const size_t tstep = 2 * hstep;
    const unsigned ldsw = (unsigned)wid * 1024u;
    const int aoff = lds_byte(wr * 64 + fr, fq * 8), boff = lds_byte(wc * 32 + fr, fq * 8);
#define PG8_SA(b, h) (((b) * 2 + (h)) * HTB)
#define PG8_SB(b, h) ((4 + (b) * 2 + (h)) * HTB)
#define PG8_STAGE(bufoff, gbase, voff) do { _Pragma("unroll") for (int _i = 0; _i < 2; ++_i) \
        __builtin_amdgcn_global_load_lds((const unsigned*)((const char*)(gbase) + (voff)[_i]), (PG8_LAS unsigned*)(lds + (bufoff) + ldsw + _i * 8192), 16, 0, 0); } while (0)
#define PG8_LDA(dst, b, h) do { _Pragma("unroll") for (int m = 0; m < 4; ++m) _Pragma("unroll") for (int k = 0; k < 2; ++k) dst[m][k] = *(const PG8_LAS bf16x8*)(lds + PG8_SA(b, h) + aoff + m * 2048 + k * 1024); } while (0)
#define PG8_LDB(dst, b, h) do { _Pragma("unroll") for (int n = 0; n < 2; ++n) _Pragma("unroll") for (int k = 0; k < 2; ++k) dst[n][k] = *(const PG8_LAS bf16x8*)(lds + PG8_SB(b, h) + boff + n * 2048 + k * 1024); } while (0)
#define PG8_MMA(ai, bj, At, Bt) do { __builtin_amdgcn_s_setprio(1); _Pragma("unroll") for (int m = 0; m < 4; ++m) _Pragma("unroll") for (int n = 0; n < 2; ++n) _Pragma("unroll") for (int k = 0; k < 2; ++k) \
        acc[ai][bj][m][n] = __builtin_amdgcn_mfma_f32_16x16x32_bf16(Bt[n][k], At[m][k], acc[ai][bj][m][n], 0, 0, 0); __builtin_amdgcn_s_setprio(0); } while (0)
#define PG8_WAIT_V(n) asm volatile("s_waitcnt vmcnt(" #n ")" ::: "memory")
#define PG8_WAIT_L(n) asm volatile("s_waitcnt lgkmcnt(" #n ")" ::: "memory")
#define PG8_BAR __builtin_amdgcn_s_barrier()
#define PG8_SCHED __builtin_amdgcn_sched_barrier(0)
    Unit cur, nxt; int ui = 0;
    if (!S.next(0, cur)) return;
    f32x4 acc[2][2][4][2];
#pragma unroll
    for (int a = 0; a < 2; ++a)
#pragma unroll
        for (int b = 0; b < 2; ++b)
#pragma unroll
            for (int m = 0; m < 4; ++m)
#pragma unroll
                for (int n = 0; n < 2; ++n) acc[a][b][m][n] = (f32x4){0.f, 0.f, 0.f, 0.f};
    bf16x8 At[4][2], B0[2][2], B1[2][2];
    const char* cA = (const char*)g.A + (size_t)cur.pm * tstep; const char* cB = (const char*)g.Bt + (size_t)cur.pn * tstep;
    S.a_ready(cur);
    if constexpr (SP2) {
        PG8_STAGE(PG8_SB(0, 0), cB, voffB); PG8_STAGE(PG8_SB(0, 1), cB + hstep, voffB); PG8_STAGE(PG8_SA(0, 0), cA, voffA); PG8_STAGE(PG8_SA(0, 1), cA + hstep, voffA);
        if (wr == 1) PG8_BAR;
        PG8_WAIT_V(2); PG8_BAR;
        PG8_STAGE(PG8_SB(1, 0), cB + kstep, voffB); PG8_STAGE(PG8_SA(1, 0), cA + kstep, voffA); PG8_STAGE(PG8_SB(1, 1), cB + hstep + kstep, voffB);
        PG8_WAIT_V(6); PG8_BAR;
    } else {
        PG8_STAGE(PG8_SB(0, 0), cB, voffB); PG8_STAGE(PG8_SA(0, 0), cA, voffA); PG8_STAGE(PG8_SB(0, 1), cB + hstep, voffB); PG8_STAGE(PG8_SA(0, 1), cA + hstep, voffA);
        if (wr == 1) PG8_BAR;
        PG8_WAIT_V(4); PG8_BAR;
        PG8_STAGE(PG8_SB(1, 0), cB + kstep, voffB); PG8_STAGE(PG8_SA(1, 0), cA + kstep, voffA); PG8_STAGE(PG8_SB(1, 1), cB + hstep + kstep, voffB);
        PG8_WAIT_V(6); PG8_BAR;
    }
    for (;;) {
        const bool has_next = S.next(ui + 1, nxt);
        const char* nA = has_next ? (const char*)g.A + (size_t)nxt.pm * tstep : cA; const char* nB = has_next ? (const char*)g.Bt + (size_t)nxt.pn * tstep : cB;
        for (int t = 0; t < nt; t += 2) {
            const bool last = (t == nt - 2);
            const char* a1 = cA + (size_t)(t + 1) * kstep;
            const char* a2 = last ? nA : cA + (size_t)(t + 2) * kstep; const char* b2 = last ? nB : cB + (size_t)(t + 2) * kstep;
            const char* a3 = a2 + kstep; const char* b3 = b2 + kstep;
            if (last && has_next) S.a_ready(nxt);
            if constexpr (SP2) {
            PG8_LDB(B0, 0, 0); PG8_LDB(B1, 0, 1); PG8_SCHED; PG8_LDA(At, 0, 0); PG8_STAGE(PG8_SA(1, 1), a1 + hstep, voffA);
            PG8_WAIT_V(8); PG8_WAIT_L(0); PG8_BAR; PG8_MMA(0, 0, At, B0); PG8_MMA(0, 1, At, B1); PG8_BAR; PG8_SCHED;
            PG8_LDA(At, 0, 1); PG8_STAGE(PG8_SB(0, 0), b2, voffB); PG8_STAGE(PG8_SB(0, 1), b2 + hstep, voffB); PG8_STAGE(PG8_SA(0, 0), a2, voffA);
            PG8_WAIT_V(8); PG8_WAIT_L(0); PG8_BAR; PG8_MMA(1, 0, At, B0); PG8_MMA(1, 1, At, B1); PG8_BAR; PG8_SCHED;
            PG8_LDB(B0, 1, 0); PG8_LDB(B1, 1, 1); PG8_SCHED; PG8_LDA(At, 1, 0); PG8_STAGE(PG8_SA(0, 1), a2 + hstep, voffA);
            PG8_WAIT_V(8); PG8_WAIT_L(0); PG8_BAR; PG8_MMA(0, 0, At, B0); PG8_MMA(0, 1, At, B1); PG8_BAR; PG8_SCHED;
            PG8_LDA(At, 1, 1); PG8_STAGE(PG8_SB(1, 0), b3, voffB); PG8_STAGE(PG8_SB(1, 1), b3 + hstep, voffB); PG8_STAGE(PG8_SA(1, 0), a3, voffA);
            PG8_WAIT_V(8); PG8_WAIT_L(0); PG8_BAR; PG8_MMA(1, 0, At, B0); PG8_MMA(1, 1, At, B1); PG8_BAR; PG8_SCHED;
            } else {
            PG8_LDB(B0, 0, 0); PG8_SCHED; PG8_LDA(At, 0, 0); PG8_STAGE(PG8_SA(1, 1), a1 + hstep, voffA);
            PG8_WAIT_L(8); PG8_BAR; PG8_WAIT_L(0); PG8_MMA(0, 0, At, B0); PG8_BAR; PG8_SCHED;
            PG8_LDB(B1, 0, 1); PG8_STAGE(PG8_SB(0, 0), b2, voffB);
            PG8_BAR; PG8_WAIT_L(0); PG8_MMA(0, 1, At, B1); PG8_BAR;
            PG8_LDA(At, 0, 1); PG8_STAGE(PG8_SA(0, 0), a2, voffA);
            PG8_BAR; PG8_WAIT_L(0); PG8_MMA(1, 0, At, B0); PG8_BAR; PG8_SCHED;
            PG8_STAGE(PG8_SB(0, 1), b2 + hstep, voffB);
            PG8_WAIT_V(6); PG8_BAR; PG8_MMA(1, 1, At, B1); PG8_BAR;
            PG8_LDB(B0, 1, 0); PG8_SCHED; PG8_LDA(At, 1, 0); PG8_STAGE(PG8_SA(0, 1), a2 + hstep, voffA);
            PG8_WAIT_L(8); PG8_BAR; PG8_WAIT_L(0); PG8_MMA(0, 0, At, B0); PG8_BAR; PG8_SCHED;
            PG8_LDB(B1, 1, 1); PG8_STAGE(PG8_SB(1, 0), b3, voffB);
            PG8_BAR; PG8_WAIT_L(0); PG8_MMA(0, 1, At, B1); PG8_BAR;
            PG8_LDA(At, 1, 1); PG8_STAGE(PG8_SA(1, 0), a3, voffA);
            PG8_BAR; PG8_WAIT_L(0); PG8_MMA(1, 0, At, B0); PG8_BAR; PG8_SCHED;
            PG8_STAGE(PG8_SB(1, 1), b3 + hstep, voffB);
            PG8_WAIT_V(6); PG8_BAR; PG8_MMA(1, 1, At, B1); PG8_BAR;
            }
        }
        if constexpr (ALIGN_EPI) { if (wr == 0) PG8_BAR; }
        if constexpr (!Epi::AFTER_DRAIN) { E(acc, cur, wr, wc, fr, fq); S.done(cur); }
        if (!has_next) break;
#pragma unroll
        for (int a = 0; a < 2; ++a)
#pragma unroll
            for (int b = 0; b < 2; ++b)
#pragma unroll
                for (int m = 0; m < 4; ++m)
#pragma unroll
                    for (int n = 0; n < 2; ++n) acc[a][b][m][n] = (f32x4){0.f, 0.f, 0.f, 0.f};
        cur = nxt; cA = nA; cB = nB; ++ui;
        if constexpr (ALIGN_EPI) { if (wr == 1) PG8_BAR; }
    }
    PG8_WAIT_V(0);
    if constexpr (!ALIGN_EPI) { if (wr == 0) PG8_BAR; }
    PG8_BAR;
    if constexpr (Epi::AFTER_DRAIN) { E.fused(acc, cur, wr, wc, fr, fq, lds, wid, lane); S.done(cur); }
#undef PG8_SA
#undef PG8_SB
#undef PG8_STAGE
#undef PG8_LDA
#undef PG8_LDB
#undef PG8_MMA
#undef PG8_WAIT_V
#undef PG8_WAIT_L
#undef PG8_BAR
#undef PG8_SCHED
}
}
__device__ __forceinline__ bf16* ws_wt(const Params& P, int l, size_t off) { return (bf16*)(P.ws + WS_WT + (size_t)l * WT_STRIDE + off); }
__device__ __forceinline__ bf16* ws_h(const Params& P) { return (bf16*)(P.ws + WS_H); }
__device__ __forceinline__ bf16* ws_proj(const Params& P, int b = 0) { (void)b; return (bf16*)(P.ws + WS_PROJ); }
__device__ __forceinline__ bf16* ws_ff(const Params& P) { return (bf16*)(P.ws + WS_PROJ); }
__device__ __forceinline__ bf16* ws_mixed(const Params& P) { return (bf16*)(P.ws + WS_MIXED); }

__device__ __forceinline__ void transpose_item(const float* W, int ldw, int col0, int ncols, bf16* WT, int ldt, int drow0, int k0, LAS float* scr, int lane, const float* gk = nullptr) {
    const int rr = lane >> 4, c4 = (lane & 15) * 4; f32x4 v[16];
#pragma unroll
    for (int i = 0; i < 16; ++i) v[i] = (c4 < ncols) ? __builtin_nontemporal_load((const f32x4*)(W + (size_t)(k0 + 4 * i + rr) * ldw + col0 + c4)) : (f32x4){0.f, 0.f, 0.f, 0.f};
    if (gk) {
#pragma unroll
        for (int i = 0; i < 16; ++i) v[i] = v[i] * gk[k0 + 4 * i + rr]; }
#pragma unroll
    for (int i = 0; i < 16; ++i) { LAS float* d = scr + (4 * i + rr) * 65 + c4; d[0] = v[i].x; d[1] = v[i].y; d[2] = v[i].z; d[3] = v[i].w; }
    LDS_WAIT();
    const int c8 = lane & 7;
#pragma unroll
    for (int j = 0; j < 8; ++j) { const int n = (lane >> 3) + 8 * j; const LAS float* s = scr + (8 * c8) * 65 + n;
        u32x4 o; o.x = pk2(s[0 * 65], s[1 * 65]); o.y = pk2(s[2 * 65], s[3 * 65]); o.z = pk2(s[4 * 65], s[5 * 65]); o.w = pk2(s[6 * 65], s[7 * 65]);
        if (n < ncols) *(u32x4*)(WT + (size_t)(drow0 + n) * ldt + k0 + 8 * c8) = o; }
    LDS_WAIT();
}
constexpr int CV_IN = 81 * 32, CV_OUT = 32 * 32, CV_GU = 88 * 32, CV_DN = 32 * 88, CV_PW = 16, CV_LAYER = CV_IN + CV_OUT + 3 * CV_GU + CV_PW;
static_assert(CV_GU == CV_DN, "gate/up/down item counts");
__device__ __forceinline__ void ph_convert(const Params& P, const Ctx& C) {
    LAS float* scr = (LAS float*)(C.lds + C.wave * 16640);
    const int gw = C.bid * 8 + C.wave, NGW = C.G * 8;
    for (int it = gw; it < DEPTH * CV_LAYER; it += NGW) {
        const int l = it / CV_LAYER; int r = it % CV_LAYER;
        if (r < CV_IN) { const int nb = r % 81, kb = r / 81; int col0, drow0, nc = 64;
            if (nb < 72) { col0 = 64 * nb; drow0 = 64 * nb;
                if ((unsigned)(nb - 8) < 16u) { const int cb = (nb - 8) & 7; drow0 = 512 + 256 * (cb >> 1) + 128 * ((nb - 8) >> 3) + 64 * (cb & 1); } }
            else if (nb < 80) { col0 = 4624 + 64 * (nb - 72); drow0 = 4608 + 64 * (nb - 72); } else { col0 = 4608; drow0 = NPROJ; nc = 16; }
            transpose_item(P.w_in + (size_t)l * D_MODEL * IN_COLS, IN_COLS, col0, nc, ws_wt(P, l, WT_IN), D_MODEL, drow0, 64 * kb, scr, C.lane, P.norm1_g + l * D_MODEL); continue; }
        r -= CV_IN;
        if (r < CV_OUT) { const int nb = r % 32, kb = r / 32;
            transpose_item(P.w_out + (size_t)l * D_MODEL * D_MODEL, D_MODEL, 64 * nb, 64, ws_wt(P, l, WT_OUT), D_MODEL, 64 * nb, 64 * kb, scr, C.lane); continue; }
        r -= CV_OUT;
        if (r < 2 * CV_GU) { const int up = r >= CV_GU; if (up) r -= CV_GU; const int nb = r % 88, kb = r / 88;
            transpose_item((up ? P.w_up : P.w_gate) + (size_t)l * D_MODEL * DFF, DFF, 64 * nb, 64, ws_wt(P, l, WT_GU), D_MODEL, 256 * (nb >> 1) + 64 * (nb & 1) + (up ? 128 : 0), 64 * kb, scr, C.lane, P.norm2_g + l * D_MODEL); continue; }
        r -= 2 * CV_GU;
        if (r < CV_DN) { const int nb = r % 32, kb = r / 32;
            transpose_item(P.w_down + (size_t)l * DFF * D_MODEL, D_MODEL, 64 * nb, 64, ws_wt(P, l, WT_DN), DFF, 64 * nb, 64 * kb, scr, C.lane); continue; }
        r -= CV_DN;
        { const int g = r >> 2, nb = r & 1, kb = (r >> 1) & 1;
            transpose_item(P.pool_w + (size_t)(l * 4 + g) * 128 * 128, 128, 64 * nb, 64, ws_wt(P, l, WT_PW) + (size_t)g * 128 * 128, 128, 64 * nb, 64 * kb, scr, C.lane); }
    }
}

__device__ __forceinline__ unsigned long long* ws_rss(const Params& P, int which) { return (unsigned long long*)(P.ws + WS_GA) + which * MTOK; }
__device__ __forceinline__ void ph_x0(const float* x, bf16* xb, unsigned long long* rss, const Ctx& C) {
    const int gw = C.bid * 8 + C.wave, NGW = C.G * 8;
    for (int m = gw; m < MTOK; m += NGW) {
        const f32x4* xr = (const f32x4*)(x + (size_t)m * D_MODEL) + C.lane;
        f32x4 v[8]; float s = 0.f; u32x2 w[8];
#pragma unroll
        for (int j = 0; j < 8; ++j) v[j] = xr[64 * j];
#pragma unroll
        for (int j = 0; j < 8; ++j) { w[j].x = pk2(v[j].x, v[j].y); w[j].y = pk2(v[j].z, v[j].w); const float a = bflo(w[j].x), b = bfhi(w[j].x), c = bflo(w[j].y), d = bfhi(w[j].y); s += (a * a + b * b) + (c * c + d * d); }
        s = wave_sum(s);
        if (C.lane == 0) __hip_atomic_store(rss + m, (unsigned long long)(s * 1048576.0f + 0.5f), __ATOMIC_RELAXED, __HIP_MEMORY_SCOPE_AGENT);
        u32x2* o8 = (u32x2*)(xb + (size_t)m * D_MODEL) + C.lane;
#pragma unroll
        for (int j = 0; j < 8; ++j) o8[64 * j] = w[j];
    }
}
__device__ __forceinline__ void zero_rss(unsigned long long* rss, const Ctx& C) { if (C.tid < 64) __hip_atomic_store(rss + SEQ * C.grp + 64 * (4 * (C.rk & 7) + (C.rk >> 3)) + C.tid, 0ull, __ATOMIC_RELAXED, __HIP_MEMORY_SCOPE_AGENT); }

typedef float f32x16 __attribute__((ext_vector_type(16)));
typedef short s16x4 __attribute__((ext_vector_type(4)));
typedef short v4i16_t __attribute__((ext_vector_type(4)));
#define MFMA16(a, b, c) __builtin_amdgcn_mfma_f32_16x16x32_bf16((a), (b), (c), 0, 0, 0)
#define MFMA32(a, b, c) __builtin_amdgcn_mfma_f32_32x32x16_bf16((a), (b), (c), 0, 0, 0)
__device__ __forceinline__ s16x4 lds_tr(const LAS unsigned char* p) { return __builtin_bit_cast(s16x4, __builtin_amdgcn_ds_read_tr16_b64_v4i16((LAS v4i16_t*)p)); }
__device__ __forceinline__ bf16x8 cat8(s16x4 lo, s16x4 hi) { return __builtin_shufflevector(lo, hi, 0, 1, 2, 3, 4, 5, 6, 7); }
typedef __bf16 bf16x2_t __attribute__((ext_vector_type(2)));
__device__ __forceinline__ unsigned cvtpk(float lo, float hi) { const f32x2 v = {lo, hi}; const bf16x2_t b = __builtin_convertvector(v, bf16x2_t); return __builtin_bit_cast(unsigned, b); }
__device__ __forceinline__ float fexp2(float x) { return __builtin_amdgcn_exp2f(x); }
__device__ __forceinline__ float flog2(float x) { return __builtin_amdgcn_logf(x); }
constexpr float LOG2E = 1.4426950408889634f;

constexpr size_t SCR_KF = 16 * MiB, SCR_BCUM = 48 * MiB, SCR_UT = 64 * MiB, SCR_ST = 96 * MiB, SCR_BYTES = 112 * MiB;
static_assert(WS_SCR + SCR_BYTES <= WS_END, "scratch map");
__device__ __forceinline__ bf16* scr_bf(const Params& P, size_t off) { return (bf16*)(P.ws + WS_SCR + off); }
__device__ __forceinline__ float* scr_f32(const Params& P, size_t off) { return (float*)(P.ws + WS_SCR + off); }

__device__ __forceinline__ float log2_sigmoid(float x) { const float z = x * LOG2E; return fminf(z, 0.f) - flog2(1.0f + fexp2(-fabsf(z))); }
__device__ __forceinline__ void unpack8(const u32x4 v, float (&f)[8]) { f[0] = bflo(v.x); f[1] = bfhi(v.x); f[2] = bflo(v.y); f[3] = bfhi(v.y); f[4] = bflo(v.z); f[5] = bfhi(v.z); f[6] = bflo(v.w); f[7] = bfhi(v.w); }

__device__ __forceinline__ void m1_conv(const Params& P, int l, int chunk, const Ctx& C) {
    const bf16* proj = ws_proj(P, C.grp); bf16* mixed = ws_mixed(P); const float* cw = P.conv_w + (size_t)l * 3 * GW;
    const int c8 = (C.tid & 63) * 8, tq = C.tid >> 6, m0 = chunk * 64 + 8 * tq, t0 = m0 & (SEQ - 1);
    u32x4 cc[10], bb[8];
#pragma unroll
    for (int i = 0; i < 10; ++i) { const bool ok = (t0 - 2 + i) >= 0; const size_t row = (size_t)(ok ? m0 - 2 + i : m0);
        cc[i] = *(const u32x4*)(proj + row * PROJ_LD + PC_CC + c8);
        if (!ok) { cc[i] = (u32x4){0u, 0u, 0u, 0u}; } }
#pragma unroll
    for (int i = 0; i < 8; ++i) bb[i] = *(const u32x4*)(proj + (size_t)(m0 + i) * PROJ_LD + PC_CB + c8);
    float w[3][8];
#pragma unroll
    for (int i = 0; i < 3; ++i) { const f32x4 w0 = *(const f32x4*)(cw + i * GW + c8), w1 = *(const f32x4*)(cw + i * GW + c8 + 4); w[i][0] = w0.x; w[i][1] = w0.y; w[i][2] = w0.z; w[i][3] = w0.w; w[i][4] = w1.x; w[i][5] = w1.y; w[i][6] = w1.z; w[i][7] = w1.w; }
    float u[10][8];
#pragma unroll
    for (int i = 0; i < 10; ++i) unpack8(cc[i], u[i]);
#pragma unroll
    for (int i = 0; i < 8; ++i) { float bv[8], y[8]; unpack8(bb[i], bv);
#pragma unroll
        for (int e = 0; e < 8; ++e) y[e] = bv[e] * (w[0][e] * u[i][e] + w[1][e] * u[i + 1][e] + w[2][e] * u[i + 2][e]);
        u32x4 o; o.x = cvtpk(y[0], y[1]); o.y = cvtpk(y[2], y[3]); o.z = cvtpk(y[4], y[5]); o.w = cvtpk(y[6], y[7]);
        *(u32x4*)(mixed + (size_t)(m0 + i) * D_MODEL + MC_CONV + c8) = o; }
}

constexpr int PL_STRIDE = 136;
template <int W> __device__ __forceinline__ void pool_rows(const bf16* up  , int t0  , LAS bf16* dst  ) {
    u32x4 raw[W + 7];
#pragma unroll
    for (int i = 0; i < W + 7; ++i) { const int dt = i - (W - 1); const bool ok = (t0 + dt) >= 0; raw[i] = *(const u32x4*)(up + (ptrdiff_t)(ok ? dt : 0) * PROJ_LD); if (!ok) raw[i] = (u32x4){0u, 0u, 0u, 0u}; }
    float S[8];
#pragma unroll
    for (int e = 0; e < 8; ++e) S[e] = 0.f;
#pragma unroll
    for (int i = 0; i < W - 1; ++i) { float f[8]; unpack8(raw[i], f);
#pragma unroll
        for (int e = 0; e < 8; ++e) S[e] += f[e]; }
#pragma unroll
    for (int tk = 0; tk < 8; ++tk) { float f[8], g[8], y[8]; unpack8(raw[W - 1 + tk], f); unpack8(raw[tk], g);
        const int t = t0 + tk; const float inv = 1.0f / (float)((t + 1 < W) ? t + 1 : W);
#pragma unroll
        for (int e = 0; e < 8; ++e) { S[e] += f[e]; y[e] = S[e] * inv - f[e]; S[e] -= g[e]; }
        u32x4 o; o.x = cvtpk(y[0], y[1]); o.y = cvtpk(y[2], y[3]); o.z = cvtpk(y[4], y[5]); o.w = cvtpk(y[6], y[7]);
        *(LAS u32x4*)(dst + tk * PL_STRIDE) = o; }
}
__device__ __forceinline__ void m1_pool(const Params& P, int l, int chunk, const Ctx& C) {
    const bf16* proj = ws_proj(P, C.grp); bf16* mixed = ws_mixed(P);
    LAS bf16* PLs = (LAS bf16*)C.lds;
    const int m0 = chunk * 64, t0 = m0 & (SEQ - 1);
    __syncthreads();
    bf16x8 paf[4][4]; f32x4 psc[4];
    { const int g = C.wave >> 1, nh = C.wave & 1, li = C.lane & 15, lg = C.lane >> 4; const bf16* pw = ws_wt(P, l, WT_PW) + (size_t)g * 128 * 128;
#pragma unroll
      for (int d4 = 0; d4 < 4; ++d4) { const int dt = 4 * nh + d4;
#pragma unroll
          for (int ks = 0; ks < 4; ++ks) paf[d4][ks] = *(const bf16x8*)(pw + (size_t)(16 * dt + li) * 128 + 32 * ks + 8 * lg);
          psc[d4] = *(const f32x4*)(P.pool_scale + l * GW + g * 128 + 16 * dt + 4 * lg); } }
    { const int g = C.wave >> 1, cg = C.lane & 15, tq = (C.wave & 1) * 4 + (C.lane >> 4), ch = g * 128 + cg * 8;
      const bf16* up = proj + (size_t)(m0 + 8 * tq) * PROJ_LD + PC_PU + ch; LAS bf16* dst = PLs + (g * 64 + 8 * tq) * PL_STRIDE + cg * 8;
      if (g == 0) pool_rows<2>(up, t0 + 8 * tq, dst); else if (g == 1) pool_rows<4>(up, t0 + 8 * tq, dst); else if (g == 2) pool_rows<8>(up, t0 + 8 * tq, dst); else pool_rows<16>(up, t0 + 8 * tq, dst); }
    __syncthreads();
    { const int g = C.wave >> 1, nh = C.wave & 1, li = C.lane & 15, lg = C.lane >> 4;
#pragma unroll
      for (int d4 = 0; d4 < 4; ++d4) { const int dt = 4 * nh + d4;
#pragma unroll
          for (int tt = 0; tt < 4; ++tt) { f32x4 acc = {0.f, 0.f, 0.f, 0.f};
#pragma unroll
              for (int ks = 0; ks < 4; ++ks) { const bf16x8 bfr = *(const LAS bf16x8*)(PLs + (g * 64 + 16 * tt + li) * PL_STRIDE + 32 * ks + 8 * lg); acc = MFMA16(paf[d4][ks], bfr, acc); }
              u32x2 o; o.x = cvtpk(acc[0] * psc[d4][0], acc[1] * psc[d4][1]); o.y = cvtpk(acc[2] * psc[d4][2], acc[3] * psc[d4][3]);
              *(u32x2*)(mixed + (size_t)(m0 + 16 * tt + li) * D_MODEL + MC_POOL + g * 128 + 16 * dt + 4 * lg) = o; } } }
}


constexpr float SB_QSCALE = 0.08838834764831845f * LOG2E;
typedef __bf16 bf16x2v __attribute__((ext_vector_type(2)));
__device__ __forceinline__ float dot2sq(unsigned w, float acc) { const bf16x2v v = __builtin_bit_cast(bf16x2v, w); return __builtin_amdgcn_fdot2_f32_bf16(v, v, acc, false); }
constexpr int SBV_STRIDE = 320;
constexpr int SBV_TILE = 32 * SBV_STRIDE, SB_RK_OFF = 8 * SBV_TILE;
__device__ __forceinline__ void m2_sb(const Params& P, int l, const Ctx& C) {
    bf16* mixed = ws_mixed(P);
    const int lane = C.lane, q = lane & 31, hi = lane >> 5;
    __syncthreads();
    {
        const int bh = 4 * C.grp + (C.rk >> 3), j8 = C.rk & 7, strip = (C.wave < 4) ? 4 * j8 + C.wave : 63 - 4 * j8 - (C.wave - 4);
        const int b = bh >> 2, h = bh & 3;
        const bf16* pb = ws_proj(P, C.grp) + (size_t)b * SEQ * PROJ_LD;
        const bf16* kbase = scr_bf(P, SCR_KF) + (size_t)bh * 64 * 4096 + lane * 8;
        const bf16* vcol = pb + (size_t)(lane >> 4) * PROJ_LD + PC_SV + h * 128 + 8 * (lane & 15);
        LAS unsigned char* vt = C.lds + C.wave * SBV_TILE; LAS float* rkl = (LAS float*)(C.lds + SB_RK_OFF + C.wave * 128);
        LAS unsigned char* vw = vt + (lane >> 4) * SBV_STRIDE + (lane & 15) * 16;
        const LAS unsigned char* vr = vt + (4 * hi + ((lane >> 2) & 3)) * SBV_STRIDE + (16 * ((lane >> 4) & 1) + 4 * (lane & 3)) * 2;
        bf16x8 qf[8], kf[8];
        { const bf16* qp = pb + (size_t)(strip * 32 + q) * PROJ_LD + PC_SQ + h * 128 + 8 * hi; u32x4 xq[8];
#pragma unroll
          for (int s = 0; s < 8; ++s) xq[s] = *(const u32x4*)(qp + 16 * s);
#pragma unroll
          for (int s = 0; s < 8; ++s) kf[s] = *(const bf16x8*)(kbase + (size_t)strip * 4096 + s * 512);
          float ss = 0.f;
#pragma unroll
          for (int s = 0; s < 8; ++s) { ss = dot2sq(xq[s].x, ss); ss = dot2sq(xq[s].y, ss); ss = dot2sq(xq[s].z, ss); ss = dot2sq(xq[s].w, ss); }
          ss += __shfl_xor(ss, 32);
          const float rq = SB_QSCALE / sqrtf(ss * (1.0f / 128.f) + RMS_EPS); const float* qg = P.sb_q_g + l * 128 + 8 * hi; const float* kg = P.sb_k_g + l * 128 + 8 * hi;
#pragma unroll
          for (int s = 0; s < 8; ++s) { float f[8]; unpack8(xq[s], f); const f32x4 g0 = *(const f32x4*)(qg + 16 * s) * *(const f32x4*)(kg + 16 * s) * rq, g1 = *(const f32x4*)(qg + 16 * s + 4) * *(const f32x4*)(kg + 16 * s + 4) * rq;
              u32x4 o; o.x = cvtpk(f[0] * g0.x, f[1] * g0.y); o.y = cvtpk(f[2] * g0.z, f[3] * g0.w); o.z = cvtpk(f[4] * g1.x, f[5] * g1.y); o.w = cvtpk(f[6] * g1.z, f[7] * g1.w);
              qf[s] = __builtin_bit_cast(bf16x8, o); } }
        f32x16 O[4];
#pragma unroll
        for (int mt = 0; mt < 4; ++mt)
#pragma unroll
            for (int r = 0; r < 16; ++r) O[mt][r] = 0.f;
        float carry = 0.f;
        for (int kt = strip; kt >= 0; --kt) {
            u32x4 xv[8];
#pragma unroll
            for (int i = 0; i < 8; ++i) xv[i] = *(const u32x4*)(vcol + (size_t)(kt * 32 + 4 * i) * PROJ_LD);
            __builtin_amdgcn_sched_barrier(0);
            f32x16 S;
#pragma unroll
            for (int r = 0; r < 16; ++r) S[r] = 0.f;
#pragma unroll
            for (int s = 0; s < 8; ++s) S = MFMA32(kf[s], qf[s], S);
            { float ss = 0.f;
#pragma unroll
              for (int s = 0; s < 8; ++s) { const u32x4 w = __builtin_bit_cast(u32x4, kf[s]); ss = dot2sq(w.x, ss); ss = dot2sq(w.y, ss); ss = dot2sq(w.z, ss); ss = dot2sq(w.w, ss); }
              ss += __shfl_xor(ss, 32);
              rkl[q] = 1.0f / sqrtf(ss * (1.0f / 128.f) + RMS_EPS); }
            __builtin_amdgcn_sched_barrier(0);
            { const bf16* kn = kbase + (size_t)(kt > 0 ? kt - 1 : 0) * 4096;
#pragma unroll
              for (int s = 0; s < 8; ++s) kf[s] = *(const bf16x8*)(kn + s * 512); }
            __builtin_amdgcn_sched_barrier(0);
#pragma unroll
            for (int c = 0; c < 4; ++c) { const f32x4 rk4 = *(const LAS f32x4*)(rkl + 8 * c + 4 * hi); S[4 * c] *= rk4.x; S[4 * c + 1] *= rk4.y; S[4 * c + 2] *= rk4.z; S[4 * c + 3] *= rk4.w; }
            const bool diag = (kt == strip);
            float ls[16], lr[16];
#pragma unroll
            for (int r = 0; r < 16; ++r) { const float z = S[r]; const int key = (r & 3) + 8 * (r >> 2) + 4 * hi; const bool valid = !diag || key < q;
                const float e = fexp2(-fabsf(z)), l2 = flog2(1.0f + e); ls[r] = fminf(z, 0.f) - l2; lr[r] = valid ? ls[r] - z : 0.f; if (!valid) ls[r] = -1e30f; }
            float gs[4], og[4];
#pragma unroll
            for (int c = 0; c < 4; ++c) { gs[c] = (lr[4 * c] + lr[4 * c + 1]) + (lr[4 * c + 2] + lr[4 * c + 3]); og[c] = __shfl_xor(gs[c], 32); }
            float R[4]; R[3] = 0.f; R[2] = gs[3] + og[3]; R[1] = R[2] + (gs[2] + og[2]); R[0] = R[1] + (gs[1] + og[1]);
            const float total = R[0] + (gs[0] + og[0]);
            unsigned pk[8];
#pragma unroll
            for (int c = 0; c < 4; ++c) { const float T = R[c] + (hi == 0 ? og[c] : 0.f) + carry;
                const float s3 = T, s2 = s3 + lr[4 * c + 3], s1 = s2 + lr[4 * c + 2], s0 = s1 + lr[4 * c + 1];
                const float a0 = fexp2(ls[4 * c] + s0), a1 = fexp2(ls[4 * c + 1] + s1), a2 = fexp2(ls[4 * c + 2] + s2), a3 = fexp2(ls[4 * c + 3] + s3);
                pk[2 * c] = cvtpk(a0, a1); pk[2 * c + 1] = cvtpk(a2, a3); }
            carry += total;
            bf16x8 p0, p1; { u32x4 w0 = {pk[0], pk[1], pk[2], pk[3]}, w1 = {pk[4], pk[5], pk[6], pk[7]}; p0 = __builtin_bit_cast(bf16x8, w0); p1 = __builtin_bit_cast(bf16x8, w1); }
            __builtin_amdgcn_sched_barrier(0);
#pragma unroll
            for (int i = 0; i < 8; ++i) *(LAS u32x4*)(vw + i * 4 * SBV_STRIDE) = xv[i];
#pragma unroll
            for (int mt = 0; mt < 4; ++mt) {
                const bf16x8 v0 = cat8(lds_tr(vr + 64 * mt), lds_tr(vr + 8 * SBV_STRIDE + 64 * mt));
                const bf16x8 v1 = cat8(lds_tr(vr + 16 * SBV_STRIDE + 64 * mt), lds_tr(vr + 24 * SBV_STRIDE + 64 * mt));
                O[mt] = MFMA32(v0, p0, O[mt]); O[mt] = MFMA32(v1, p1, O[mt]); }
            if (__all(carry < -135.0f)) break;
        }
        bf16* orow = mixed + ((size_t)b * SEQ + strip * 32 + q) * D_MODEL + MC_SB + h * 128;
#pragma unroll
        for (int mt = 0; mt < 4; ++mt)
#pragma unroll
            for (int c = 0; c < 4; ++c) { u32x2 o; o.x = cvtpk(O[mt][4 * c], O[mt][4 * c + 1]); o.y = cvtpk(O[mt][4 * c + 2], O[mt][4 * c + 3]);
                *(u32x2*)(orow + 32 * mt + 8 * c + 4 * hi) = o; }
    }
}
constexpr int GK_STRIDE = 72, GV_STRIDE = 136;
__device__ __forceinline__ void m1_gla_a(const Params& P, int l, int chunk, const Ctx& C) {
    const bf16* proj = ws_proj(P, C.grp); const bf16* hbuf = ws_h(P); const bf16* wa = ws_wt(P, l, WT_IN) + (size_t)NPROJ * D_MODEL;
    float* BCUM = scr_f32(P, SCR_BCUM); bf16* UT = scr_bf(P, SCR_UT);
    LAS float* Bc = (LAS float*)C.lds;
    LAS float* GAp = (LAS float*)(C.lds + 65536);
    LAS float* GAs = (LAS float*)(C.lds + 65536 + 32768);
    LAS float* AW = GAs + 1024;
    LAS float* AB = AW + 4096;
    LAS unsigned char* TK = C.lds + 65536;
    LAS unsigned char* TV = TK + 2 * 64 * GK_STRIDE * 2;
    const int m0 = chunk * 64, b = m0 >> 11, cc = (m0 & (SEQ - 1)) >> 6, tid = C.tid, lane = C.lane, li = lane & 15, lg = lane >> 4;
    u32x4 kq[2], vq[4];
#define GLA_A_ISSUE(hp_) do { _Pragma("unroll") for (int j = 0; j < 2; ++j) { const int i = tid + 512 * j, hs = i >> 9, t = (i >> 3) & 63, k8 = (i & 7) * 8, h = 2 * (hp_) + hs; \
            kq[j] = *(const u32x4*)(proj + (size_t)(m0 + t) * PROJ_LD + PC_GK + h * 64 + k8); } \
        _Pragma("unroll") for (int j = 0; j < 4; ++j) { const int i = tid + 512 * j, hs = i >> 10, t = (i >> 4) & 63, v8 = (i & 15) * 8, h = 2 * (hp_) + hs; \
            vq[j] = *(const u32x4*)(proj + (size_t)(m0 + t) * PROJ_LD + PC_GV + h * 128 + v8); } } while (0)
    GLA_A_ISSUE(0);
    __syncthreads();
    for (int i = tid; i < 4096; i += 512) AW[i] = P.gla_a_w[(size_t)l * 4096 + i];
    if (tid < 256) AB[tid] = P.gla_a_b[l * 256 + tid];
    { f32x4 acc[4];
#pragma unroll
      for (int mt = 0; mt < 4; ++mt) acc[mt] = (f32x4){0.f, 0.f, 0.f, 0.f};
#pragma unroll 8
      for (int kk = 0; kk < 8; ++kk) { const int ks = 8 * C.wave + kk;
          const bf16x8 bfr = *(const bf16x8*)(wa + (size_t)li * D_MODEL + 32 * ks + 8 * lg);
#pragma unroll
          for (int mt = 0; mt < 4; ++mt) { const bf16x8 afr = *(const bf16x8*)(hbuf + (size_t)(m0 + 16 * mt + li) * D_MODEL + 32 * ks + 8 * lg); acc[mt] = MFMA16(afr, bfr, acc[mt]); } }
#pragma unroll
      for (int mt = 0; mt < 4; ++mt)
#pragma unroll
          for (int r = 0; r < 4; ++r) GAp[(C.wave * 64 + 16 * mt + 4 * lg + r) * 16 + li] = acc[mt][r]; }
    __syncthreads();
    for (int o = tid; o < 1024; o += 512) { float s = 0.f;
#pragma unroll
        for (int w = 0; w < 8; ++w) s += GAp[w * 1024 + o];
        GAs[o] = s * (1.0f / sqrtf((float)__hip_atomic_load(ws_rss(P, 0) + m0 + (o >> 4), __ATOMIC_RELAXED, __HIP_MEMORY_SCOPE_AGENT) * (1.0f / (2048.0f * 1048576.0f)) + RMS_EPS)); }
    __syncthreads();
    { const int col = tid & 255, half = tid >> 8; float aw[16];
#pragma unroll
      for (int j = 0; j < 16; ++j) aw[j] = AW[j * 256 + col];
      const float ab = AB[col]; float run = 0.f;
      for (int t = 32 * half; t < 32 * half + 32; ++t) { float lg2 = ab;
#pragma unroll
          for (int j = 0; j < 16; ++j) lg2 += GAs[t * 16 + j] * aw[j];
          run += log2_sigmoid(lg2) * (1.0f / 16.0f); Bc[t * 256 + col] = run; } }
    __syncthreads();
    { const int col = tid & 255, half = tid >> 8;
      if (half) { const float tot = Bc[31 * 256 + col]; for (int t = 32; t < 64; ++t) Bc[t * 256 + col] += tot; } }
    __syncthreads();
    for (int i = tid; i < 64 * 64; i += 512) { const int t = i >> 6, c4 = (i & 63) * 4; const LAS float* s = Bc + t * 256 + c4; *(f32x4*)(BCUM + (size_t)(m0 + t) * 256 + c4) = (f32x4){s[0], s[1], s[2], s[3]}; }
#pragma unroll
    for (int hp = 0; hp < 2; ++hp) {
        __syncthreads();
#pragma unroll
        for (int j = 0; j < 2; ++j) { const int i = tid + 512 * j, hs = i >> 9, t = (i >> 3) & 63, k8 = (i & 7) * 8, h = 2 * hp + hs;
            const u32x4 k4 = kq[j]; const LAS float* bb = Bc + t * 256 + h * 64 + k8;
            u32x4 o; o.x = cvtpk(bflo(k4.x) * fexp2(-bb[0]), bfhi(k4.x) * fexp2(-bb[1])); o.y = cvtpk(bflo(k4.y) * fexp2(-bb[2]), bfhi(k4.y) * fexp2(-bb[3]));
            o.z = cvtpk(bflo(k4.z) * fexp2(-bb[4]), bfhi(k4.z) * fexp2(-bb[5])); o.w = cvtpk(bflo(k4.w) * fexp2(-bb[6]), bfhi(k4.w) * fexp2(-bb[7]));
            *(LAS u32x4*)(TK + ((hs * 64 + t) * GK_STRIDE + k8) * 2) = o; }
#pragma unroll
        for (int j = 0; j < 4; ++j) { const int i = tid + 512 * j, hs = i >> 10, t = (i >> 4) & 63, v8 = (i & 15) * 8;
            *(LAS u32x4*)(TV + ((hs * 64 + t) * GV_STRIDE + v8) * 2) = vq[j]; }
        if (hp == 0) GLA_A_ISSUE(1);
        __syncthreads();
        { const int hs = C.wave >> 2, qr = C.wave & 3, h = 2 * hp + hs, bh = b * 4 + h, q4 = li >> 2, p4 = li & 3;
          const LAS unsigned char* tk = TK + hs * 64 * GK_STRIDE * 2; const LAS unsigned char* tv = TV + hs * 64 * GV_STRIDE * 2;
          f32x4 acc[2][4];
#pragma unroll
          for (int a = 0; a < 2; ++a)
#pragma unroll
              for (int n = 0; n < 4; ++n) acc[a][n] = (f32x4){0.f, 0.f, 0.f, 0.f};
#pragma unroll
          for (int ks = 0; ks < 2; ++ks) { const int trow = 32 * ks + 8 * lg + q4;
              bf16x8 kfr[4];
#pragma unroll
              for (int n = 0; n < 4; ++n) kfr[n] = cat8(lds_tr(tk + (trow * GK_STRIDE + 16 * n + 4 * p4) * 2), lds_tr(tk + ((trow + 4) * GK_STRIDE + 16 * n + 4 * p4) * 2));
#pragma unroll
              for (int a = 0; a < 2; ++a) { const int v0 = 16 * (2 * qr + a);
                  const bf16x8 vfr = cat8(lds_tr(tv + (trow * GV_STRIDE + v0 + 4 * p4) * 2), lds_tr(tv + ((trow + 4) * GV_STRIDE + v0 + 4 * p4) * 2));
#pragma unroll
                  for (int n = 0; n < 4; ++n) acc[a][n] = MFMA16(kfr[n], vfr, acc[a][n]); } }
          bf16* ut = UT + ((size_t)bh * 32 + cc) * 8192;
#pragma unroll
          for (int a = 0; a < 2; ++a)
#pragma unroll
              for (int n = 0; n < 4; ++n) { u32x2 o; o.x = cvtpk(acc[a][n][0], acc[a][n][1]); o.y = cvtpk(acc[a][n][2], acc[a][n][3]);
                  *(u32x2*)(ut + (16 * (2 * qr + a) + li) * 64 + 16 * n + 4 * lg) = o; } }
    }
}
#undef GLA_A_ISSUE

__device__ __forceinline__ void m2_gla_scan(const Params& P, const Ctx& C) {
    const float* BCUM = scr_f32(P, SCR_BCUM); const bf16* UT = scr_bf(P, SCR_UT); bf16* ST = scr_bf(P, SCR_ST);
    { const int e = C.grp * 16384 + C.rk * 512 + C.tid;
        const int bh = e >> 12, v = (e >> 5) & 127, k2 = (e & 31) * 2, b = bh >> 2, h = bh & 3;
        const size_t uo0 = ((size_t)bh * 32 * 128 + v) * 64 + k2; const float* bl0 = BCUM + ((size_t)b * SEQ + 63) * 256 + h * 64 + k2;
        unsigned u[32]; f32x2 bl[32];
#pragma unroll
        for (int c = 0; c < 32; ++c) { u[c] = *(const unsigned*)(UT + uo0 + (size_t)c * 8192); bl[c] = *(const f32x2*)(bl0 + (size_t)c * 64 * 256); }
        float s0 = 0.f, s1 = 0.f;
#pragma unroll
        for (int c = 0; c < 32; ++c) { *(unsigned*)(ST + uo0 + (size_t)c * 8192) = cvtpk(s0, s1); s0 = fexp2(bl[c].x) * (s0 + bflo(u[c])); s1 = fexp2(bl[c].y) * (s1 + bfhi(u[c])); }
    }
}

__device__ __forceinline__ void m3_gla_c(const Params& P, int l, const Ctx& C) {
    const bf16* proj = ws_proj(P, C.grp); bf16* mixed = ws_mixed(P); const float* BCUM = scr_f32(P, SCR_BCUM); const bf16* ST = scr_bf(P, SCR_ST);
    const float* ng = P.gla_norm_g + l * 128;
    LAS unsigned char* TQ = C.lds;
    LAS unsigned char* TK = TQ + 2 * 64 * GK_STRIDE * 2;
    LAS unsigned char* TV = TK + 2 * 64 * GK_STRIDE * 2;
    const int tid = C.tid, lane = C.lane, li = lane & 15, lg = lane >> 4, q4 = li >> 2, p4 = li & 3;
    const int chunk = 32 * C.grp + 4 * (C.rk & 7) + (C.rk >> 3),
              m0 = chunk * 64, b = m0 >> 11, cc = (m0 & (SEQ - 1)) >> 6;
    const int hs = C.wave >> 2, tt = C.wave & 3;
#pragma unroll 1
    for (int hp = 0; hp < 2; ++hp) {
        const int h = 2 * hp + hs, bh = b * 4 + h;
        u32x4 sq[2], sk[2], sv[4]; f32x4 sb0[2], sb1[2];
#pragma unroll
        for (int j = 0; j < 2; ++j) { const int i = tid + 512 * j, hh = 2 * hp + (i >> 9), t = (i >> 3) & 63, k8 = (i & 7) * 8;
            sq[j] = *(const u32x4*)(proj + (size_t)(m0 + t) * PROJ_LD + PC_GQ + hh * 64 + k8); sk[j] = *(const u32x4*)(proj + (size_t)(m0 + t) * PROJ_LD + PC_GK + hh * 64 + k8);
            const float* bp = BCUM + (size_t)(m0 + t) * 256 + hh * 64 + k8; sb0[j] = *(const f32x4*)bp; sb1[j] = *(const f32x4*)(bp + 4); }
#pragma unroll
        for (int j = 0; j < 4; ++j) { const int i = tid + 512 * j, hh = 2 * hp + (i >> 10), t = (i >> 4) & 63, v8 = (i & 15) * 8;
            sv[j] = *(const u32x4*)(proj + (size_t)(m0 + t) * PROJ_LD + PC_GV + hh * 128 + v8); }
        const bf16* st_base = ST + ((size_t)bh * 32 + cc) * 8192; const size_t mrow = (size_t)(m0 + 16 * tt + li);
        bf16x8 stf[8][2]; u32x2 r2[8];
#pragma unroll
        for (int mv = 0; mv < 8; ++mv) {
#pragma unroll
            for (int ks = 0; ks < 2; ++ks) stf[mv][ks] = *(const bf16x8*)(st_base + (size_t)(16 * mv + li) * 64 + 32 * ks + 8 * lg);
            r2[mv] = *(const u32x2*)(proj + mrow * PROJ_LD + PC_GR + h * 128 + 16 * mv + 4 * lg); }
        __syncthreads();
#pragma unroll
        for (int j = 0; j < 2; ++j) { const int i = tid + 512 * j, hsl = i >> 9, t = (i >> 3) & 63, k8 = (i & 7) * 8;
            const float bb[8] = {sb0[j].x, sb0[j].y, sb0[j].z, sb0[j].w, sb1[j].x, sb1[j].y, sb1[j].z, sb1[j].w}; float fq[8], fk[8]; unpack8(sq[j], fq); unpack8(sk[j], fk);
#pragma unroll
            for (int e = 0; e < 8; ++e) { fq[e] *= fexp2(bb[e]) * 0.125f; fk[e] *= fexp2(-bb[e]); }
            u32x4 oq, ok; oq.x = cvtpk(fq[0], fq[1]); oq.y = cvtpk(fq[2], fq[3]); oq.z = cvtpk(fq[4], fq[5]); oq.w = cvtpk(fq[6], fq[7]);
            ok.x = cvtpk(fk[0], fk[1]); ok.y = cvtpk(fk[2], fk[3]); ok.z = cvtpk(fk[4], fk[5]); ok.w = cvtpk(fk[6], fk[7]);
            *(LAS u32x4*)(TQ + ((hsl * 64 + t) * GK_STRIDE + k8) * 2) = oq; *(LAS u32x4*)(TK + ((hsl * 64 + t) * GK_STRIDE + k8) * 2) = ok; }
#pragma unroll
        for (int j = 0; j < 4; ++j) { const int i = tid + 512 * j, hsl = i >> 10, t = (i >> 4) & 63, v8 = (i & 15) * 8; *(LAS u32x4*)(TV + ((hsl * 64 + t) * GV_STRIDE + v8) * 2) = sv[j]; }
        __syncthreads();
        const LAS unsigned char* tq = TQ + hs * 64 * GK_STRIDE * 2; const LAS unsigned char* tk = TK + hs * 64 * GK_STRIDE * 2; const LAS unsigned char* tv = TV + hs * 64 * GV_STRIDE * 2;
        bf16x8 bq[2];
#pragma unroll
        for (int ks = 0; ks < 2; ++ks) bq[ks] = *(const LAS bf16x8*)(tq + ((16 * tt + li) * GK_STRIDE + 32 * ks + 8 * lg) * 2);
        bf16x8 bp[2];
#pragma unroll
        for (int kb = 0; kb < 2; ++kb) { unsigned w[4] = {0u, 0u, 0u, 0u};
            if (2 * kb <= tt) {
#pragma unroll
                for (int x = 0; x < 2; ++x) { const int st = 2 * kb + x; f32x4 a = {0.f, 0.f, 0.f, 0.f};
                    if (st <= tt) {
#pragma unroll
                        for (int ks = 0; ks < 2; ++ks) { const bf16x8 ak = *(const LAS bf16x8*)(tk + ((16 * st + li) * GK_STRIDE + 32 * ks + 8 * lg) * 2); a = MFMA16(ak, bq[ks], a); }
                        if (st == tt) {
#pragma unroll
                            for (int r = 0; r < 4; ++r) if (4 * lg + r > li) a[r] = 0.f; } }
                    w[2 * x] = cvtpk(a[0], a[1]); w[2 * x + 1] = cvtpk(a[2], a[3]); } }
            u32x4 wv = {w[0], w[1], w[2], w[3]}; bp[kb] = __builtin_bit_cast(bf16x8, wv); }
        f32x4 acc[8];
#pragma unroll
        for (int mv = 0; mv < 8; ++mv) { acc[mv] = (f32x4){0.f, 0.f, 0.f, 0.f};
#pragma unroll
            for (int ks = 0; ks < 2; ++ks) acc[mv] = MFMA16(stf[mv][ks], bq[ks], acc[mv]);
#pragma unroll
            for (int kb = 0; kb < 2; ++kb) { if (2 * kb <= tt) { const int r0 = 32 * kb + 4 * lg + q4;
                const bf16x8 av = cat8(lds_tr(tv + (r0 * GV_STRIDE + 16 * mv + 4 * p4) * 2), lds_tr(tv + ((r0 + 16) * GV_STRIDE + 16 * mv + 4 * p4) * 2));
                acc[mv] = MFMA16(av, bp[kb], acc[mv]); } } }
        float ss = 0.f;
#pragma unroll
        for (int mv = 0; mv < 8; ++mv) ss += (acc[mv][0] * acc[mv][0] + acc[mv][1] * acc[mv][1]) + (acc[mv][2] * acc[mv][2] + acc[mv][3] * acc[mv][3]);
        ss += __shfl_xor(ss, 16); ss += __shfl_xor(ss, 32);
        const float rstd = 1.0f / sqrtf(ss * (1.0f / 128.f) + RMS_EPS);
#pragma unroll
        for (int mv = 0; mv < 8; ++mv) { const int v4 = 16 * mv + 4 * lg; const f32x4 g4 = *(const f32x4*)(ng + v4);
            const float rr[4] = {bflo(r2[mv].x), bfhi(r2[mv].x), bflo(r2[mv].y), bfhi(r2[mv].y)}; float y[4];
#pragma unroll
            for (int r = 0; r < 4; ++r) y[r] = acc[mv][r] * rstd * g4[r] * rr[r] * __builtin_amdgcn_rcpf(1.0f + fexp2(-LOG2E * rr[r]));
            u32x2 o; o.x = cvtpk(y[0], y[1]); o.y = cvtpk(y[2], y[3]);
            *(u32x2*)(mixed + mrow * D_MODEL + MC_GLA + h * 128 + v4) = o; }
    }
}
constexpr int RS_LDS_OFF = 131072;
__device__ __forceinline__ void ph_gemm(const Params& P, int l, int s, const Ctx& C) {
    pg8::Gemm g; pg8::EpiAny E;
    const LAS float* rsl = (const LAS float*)(C.lds + RS_LDS_OFF);
    if (s == 0)      { g = pg8::Gemm{ws_h(P), ws_wt(P, l, WT_IN), MTOK, NPROJ, D_MODEL};      E = pg8::EpiAny{0, ws_proj(P, C.grp), nullptr, nullptr, PROJ_LD, ws_rss(P, 0), nullptr, rsl, -1}; }
    else if (s == 1) { g = pg8::Gemm{ws_mixed(P), ws_wt(P, l, WT_OUT), MTOK, D_MODEL, D_MODEL}; E = pg8::EpiAny{1, nullptr, ws_h(P), nullptr, D_MODEL, nullptr, ws_rss(P, 1), rsl, -1}; }
    else if (s == 2) { g = pg8::Gemm{ws_h(P), ws_wt(P, l, WT_GU), MTOK, NGU, D_MODEL};        E = pg8::EpiAny{2, ws_ff(P), nullptr, nullptr, DFF, ws_rss(P, 1), nullptr, rsl, -1}; }
    else             { g = pg8::Gemm{ws_ff(P), ws_wt(P, l, WT_DN), MTOK, D_MODEL, DFF};       E = pg8::EpiAny{1, nullptr, ws_h(P), (l + 1 < DEPTH) ? nullptr : P.out, D_MODEL, nullptr, ws_rss(P, 0), rsl, -1}; }
    pg8::GroupOrder S{g.N / 256, C.grp, C.rk};
    if ((s & 1) == 0) { pg8::Unit u0; if (S.next(0, u0)) { E.pm0 = u0.pm;
        if (C.tid < 256) ((LAS float*)(C.lds + RS_LDS_OFF))[C.tid] = 1.0f / sqrtf((float)__hip_atomic_load(E.rss_in + u0.pm * 256 + C.tid, __ATOMIC_RELAXED, __HIP_MEMORY_SCOPE_AGENT) * (1.0f / (2048.0f * 1048576.0f)) + RMS_EPS); }
        __syncthreads(); }
    pg8::gemm_phase<pg8::EpiAny, pg8::GroupOrder, true, true>(C.lds, g, S, E);
}

#define XB_TMO      128
#define XB_XCNT(j)  (256  + 64 * (j))
#define XB_XSUB(j)  (1280 + 64 * (j))
#define XB_XGEN(j)  (2304 + 64 * (j))
#define XB_TOP      3328
#define XB_TOPGEN   3392
#define XCD_BAR_WORDS 3456
#define XB_SPIN_CAP (1u << 18)

__device__ __forceinline__ unsigned xb_ld(unsigned* p)              { return __hip_atomic_load(p, __ATOMIC_RELAXED, __HIP_MEMORY_SCOPE_AGENT); }
__device__ __forceinline__ unsigned xb_add(unsigned* p, unsigned v) { return __hip_atomic_fetch_add(p, v, __ATOMIC_RELAXED, __HIP_MEMORY_SCOPE_AGENT); }
__device__ __forceinline__ unsigned xb_xcc_id() { return (unsigned)__builtin_amdgcn_s_getreg((3 << 11) | 20) & 0xFu; }
#define XB_SPIN(cond, bar) do { unsigned _sp = 0; while (cond) { __builtin_amdgcn_s_sleep(1); \
    if ((++_sp & 255u) == 0u) { if (xb_ld(&(bar)[XB_TMO])) break; if (_sp > XB_SPIN_CAP) { atomicAdd(&(bar)[XB_TMO], 1u); break; } } } } while (0)

struct XcdBarrier {
    unsigned* bar; unsigned x;
    volatile LAS unsigned* st;
};

__device__ __forceinline__ XcdBarrier xcd_barrier_post(unsigned* bar, volatile LAS unsigned* st) {
    XcdBarrier b; b.bar = bar; b.x = xb_xcc_id(); b.st = st;
    if (threadIdx.x == 0) (void)xb_add(&bar[XB_XCNT(b.x)], 1u);
    return b;
}
__device__ __forceinline__ void xcd_barrier_complete(unsigned* bar, unsigned x, unsigned& nloc, unsigned& nx) {
    const unsigned G = gridDim.x * gridDim.y * gridDim.z;
    unsigned sum, cnt, mine, sp = 0u;
    for (;;) {
        sum = 0u; cnt = 0u; mine = 0u;
#pragma unroll
        for (unsigned j = 0; j < 16; ++j) { const unsigned c = xb_ld(&bar[XB_XCNT(j)]); sum += c; cnt += (c > 0u) ? 1u : 0u; mine = (j == x) ? c : mine; }
        if (sum == G) break;
        __builtin_amdgcn_s_sleep(1);
        if ((++sp & 255u) == 0u) { if (xb_ld(&bar[XB_TMO])) break; if (sp > XB_SPIN_CAP) { atomicAdd(&bar[XB_TMO], 1u); break; } }
    }
    nloc = mine > 0u ? mine : 1u; nx = cnt > 0u ? cnt : 1u;
}

__device__ __forceinline__ void xcd_barrier(const XcdBarrier& b) {
    asm volatile("s_waitcnt vmcnt(0)" ::: "memory");
    __syncthreads();
    if (threadIdx.x == 0) {
        unsigned* bar = b.bar;
        __builtin_amdgcn_s_waitcnt(0);
        unsigned nloc = b.st[0], nx = b.st[1];
        if (nloc == 0u) { xcd_barrier_complete(bar, b.x, nloc, nx); b.st[0] = nloc; b.st[1] = nx; }
        const unsigned old = xb_add(&bar[XB_XSUB(b.x)], 1u);
        const unsigned gen = old / nloc;
        if (old + 1u == (gen + 1u) * nloc) {
            __builtin_amdgcn_fence(__ATOMIC_RELEASE, "agent");
            asm volatile("s_waitcnt vmcnt(0)" ::: "memory");
            const unsigned og = xb_add(&bar[XB_TOP], 1u);
            const unsigned tg = og / nx;
            if (og + 1u == (tg + 1u) * nx) xb_add(&bar[XB_TOPGEN], 1u);
            else XB_SPIN(xb_ld(&bar[XB_TOPGEN]) == tg, bar);
            __builtin_amdgcn_fence(__ATOMIC_ACQUIRE, "agent");
            xb_add(&bar[XB_XGEN(b.x)], 1u);
            asm volatile("s_waitcnt vmcnt(0)" ::: "memory");
        } else {
            XB_SPIN(xb_ld(&bar[XB_XGEN(b.x)]) == gen, bar);
            __builtin_amdgcn_fence(__ATOMIC_ACQUIRE, "agent");
            asm volatile("s_waitcnt vmcnt(0)" ::: "memory");
        }
    }
    __syncthreads();
}


__device__ __forceinline__ void xcd_barrier_complete_n(unsigned* bar, unsigned x, unsigned G, unsigned& nloc, unsigned& nx) {
    unsigned sum, cnt, mine, sp = 0u;
    for (;;) {
        sum = 0u; cnt = 0u; mine = 0u;
#pragma unroll
        for (unsigned j = 0; j < 16; ++j) { const unsigned c = xb_ld(&bar[XB_XCNT(j)]); sum += c; cnt += (c > 0u) ? 1u : 0u; mine = (j == x) ? c : mine; }
        if (sum == G) break;
        __builtin_amdgcn_s_sleep(1);
        if ((++sp & 255u) == 0u) { if (xb_ld(&bar[XB_TMO])) break; if (sp > XB_SPIN_CAP) { atomicAdd(&bar[XB_TMO], 1u); break; } }
    }
    nloc = mine > 0u ? mine : 1u; nx = cnt > 0u ? cnt : 1u;
}

__device__ __forceinline__ void xcd_barrier_n(const XcdBarrier& b, unsigned G) {
    asm volatile("s_waitcnt vmcnt(0)" ::: "memory");
    __syncthreads();
    if (threadIdx.x == 0) {
        unsigned* bar = b.bar;
        __builtin_amdgcn_s_waitcnt(0);
        unsigned nloc = b.st[0], nx = b.st[1];
        if (nloc == 0u) { xcd_barrier_complete_n(bar, b.x, G, nloc, nx); b.st[0] = nloc; b.st[1] = nx; }
        const unsigned old = xb_add(&bar[XB_XSUB(b.x)], 1u);
        const unsigned gen = old / nloc;
        if (old + 1u == (gen + 1u) * nloc) {
            __builtin_amdgcn_fence(__ATOMIC_RELEASE, "agent");
            asm volatile("s_waitcnt vmcnt(0)" ::: "memory");
            const unsigned og = xb_add(&bar[XB_TOP], 1u);
            const unsigned tg = og / nx;
            if (og + 1u == (tg + 1u) * nx) xb_add(&bar[XB_TOPGEN], 1u);
            else XB_SPIN(xb_ld(&bar[XB_TOPGEN]) == tg, bar);
            __builtin_amdgcn_fence(__ATOMIC_ACQUIRE, "agent");
            xb_add(&bar[XB_XGEN(b.x)], 1u);
            asm volatile("s_waitcnt vmcnt(0)" ::: "memory");
        } else {
            XB_SPIN(xb_ld(&bar[XB_XGEN(b.x)]) == gen, bar);
            __builtin_amdgcn_fence(__ATOMIC_ACQUIRE, "agent");
            asm volatile("s_waitcnt vmcnt(0)" ::: "memory");
        }
    }
    __syncthreads();
}


__device__ __forceinline__ void xcd_arrive_n(const XcdBarrier& b, unsigned G, volatile LAS unsigned* sp) {
    asm volatile("s_waitcnt vmcnt(0)" ::: "memory");
    __syncthreads();
    if (threadIdx.x == 0) {
        unsigned* bar = b.bar;
        __builtin_amdgcn_s_waitcnt(0);
        unsigned nloc = b.st[0], nx = b.st[1];
        if (nloc == 0u) { xcd_barrier_complete_n(bar, b.x, G, nloc, nx); b.st[0] = nloc; b.st[1] = nx; }
        const unsigned old = xb_add(&bar[XB_XSUB(b.x)], 1u);
        const unsigned gen = old / nloc;
        unsigned role = 0u, tg = 0u;
        if (old + 1u == (gen + 1u) * nloc) {
            __builtin_amdgcn_fence(__ATOMIC_RELEASE, "agent");
            asm volatile("s_waitcnt vmcnt(0)" ::: "memory");
            const unsigned og = xb_add(&bar[XB_TOP], 1u);
            tg = og / nx;
            if (og + 1u == (tg + 1u) * nx) { xb_add(&bar[XB_TOPGEN], 1u); xb_add(&bar[XB_XGEN(b.x)], 1u); role = 2u; }
            else role = 1u;
        }
        sp[0] = role; sp[1] = gen; sp[2] = tg;
    }
}
__device__ __forceinline__ void xcd_wait_n(const XcdBarrier& b, volatile LAS unsigned* sp) {
    if (threadIdx.x == 0) {
        unsigned* bar = b.bar; const unsigned role = sp[0], gen = sp[1], tg = sp[2];
        if (role == 1u) { XB_SPIN(xb_ld(&bar[XB_TOPGEN]) == tg, bar); xb_add(&bar[XB_XGEN(b.x)], 1u); }
        else if (role == 0u) XB_SPIN(xb_ld(&bar[XB_XGEN(b.x)]) == gen, bar);
        __builtin_amdgcn_fence(__ATOMIC_ACQUIRE, "agent");
        asm volatile("s_waitcnt vmcnt(0)" ::: "memory");
    }
    __syncthreads();
}


constexpr int LDS_BYTES = 147456;
constexpr int MISC_OFF = LDS_BYTES - 256;
constexpr int CW_BAR = 4096;
#ifndef SPAN_SEL
#define SPAN_SEL 0
#endif
enum { SP_CONVERT = 0, SP_NORM1, SP_GEMM_IN, SP_M1, SP_M2, SP_M3, SP_GEMM_OUT, SP_NORM2, SP_GEMM_GU, SP_GEMM_DN, SP_M1A, SP_M1B, SP_M1C, SP_M1D, SP_M2A };
__global__ void __launch_bounds__(512, 2) mk_fwd(Params P) {
    extern __shared__ __attribute__((aligned(16))) unsigned char lds[];
    Ctx C; C.lds = (LAS unsigned char*)lds; C.tid = threadIdx.x; C.lane = C.tid & 63; C.wave = __builtin_amdgcn_readfirstlane(C.tid >> 6); C.bid = blockIdx.x; C.G = gridDim.x; C.grp = C.bid & 7; C.rk = C.bid >> 3;
    volatile LAS unsigned* MISC = (volatile LAS unsigned*)(C.lds + MISC_OFF);
    if (C.tid < 64) MISC[C.tid] = 0u;
    __syncthreads();
    { unsigned* cb = (unsigned*)(P.ws + WS_CTL) + CW_BAR;
      (void)xcd_barrier_post(cb, MISC); (void)xcd_barrier_post(cb + (1 + C.grp) * XCD_BAR_WORDS, MISC + 2); (void)xcd_barrier_post(cb + (9 + 8 * C.grp + (C.rk & 7)) * XCD_BAR_WORDS, MISC + 4); }
#define MK_BAR(region, stoff, nmemb) do { XcdBarrier b_; int rg_ = (region); asm volatile("" : "+s"(rg_)); b_.bar = (unsigned*)(P.ws + WS_CTL) + CW_BAR + rg_ * XCD_BAR_WORDS; \
        b_.x = (unsigned)__builtin_amdgcn_readfirstlane((int)xb_xcc_id()); b_.st = MISC + (stoff); xcd_barrier_n(b_, (nmemb)); } while (0)
#define GRID_BAR()  MK_BAR(0, 0, (unsigned)C.G)
#define MK_SPLIT(region, stoff, call) do { XcdBarrier b_; int rg_ = (region); asm volatile("" : "+s"(rg_)); b_.bar = (unsigned*)(P.ws + WS_CTL) + CW_BAR + rg_ * XCD_BAR_WORDS; \
        b_.x = (unsigned)__builtin_amdgcn_readfirstlane((int)xb_xcc_id()); b_.st = MISC + (stoff); call; } while (0)
#define GROUP_ARRIVE() MK_SPLIT(1 + C.grp, 2, xcd_arrive_n(b_, 32u, MISC + 8))
#define GROUP_WAIT()   MK_SPLIT(1 + C.grp, 2, xcd_wait_n(b_, MISC + 8))
#define GROUP_BAR() MK_BAR(1 + C.grp, 2, 32u)
#define PANEL_BAR() MK_BAR(9 + 8 * C.grp + (C.rk & 7), 4, 4u)
#if SPAN_SEL
    volatile LAS unsigned long long* SPW = (volatile LAS unsigned long long*)(C.lds + MISC_OFF + 64);
    if (C.tid == 0) { SPW[0] = __builtin_amdgcn_s_memrealtime(); SPW[1] = 0ull; }
#define SPAN(id) do { if (C.tid == 0) { const unsigned long long n_ = __builtin_amdgcn_s_memrealtime(); if ((SPAN_SEL >> (id)) & 1) SPW[1] = SPW[1] + (n_ - SPW[0]); SPW[0] = n_; } } while (0)
#else
#define SPAN(id) do { } while (0)
#endif
#define FRESH(Cn) Ctx Cn = C; { int t_ = C.tid; asm volatile("" : "+v"(t_)); Cn.tid = t_; Cn.lane = t_ & 63; }

    { FRESH(C1); ph_convert(P, C1); }
    { FRESH(C1); ph_x0(P.x, ws_h(P), ws_rss(P, 0), C1); }
    GRID_BAR(); SPAN(SP_CONVERT);
#pragma unroll 1
    for (int l = 0; l < DEPTH; ++l) {
#pragma unroll 1
        for (int s = 0; s < 4; ++s) {
            if (s == 1) {
                { FRESH(C1); zero_rss(ws_rss(P, 1), C1); }
#if SPAN_SEL
#define SUBSPAN(id) do { VM_WAIT(); __syncthreads(); SPAN(id); } while (0)
#else
#define SUBSPAN(id) do { } while (0)
#endif
                SUBSPAN(SP_NORM1);
                { FRESH(C1); m1_gla_a(P, l, 32 * C.grp + C.rk, C1); }
                GROUP_ARRIVE();
                { FRESH(C1); m2_sb(P, l, C1); }
                GROUP_WAIT(); SPAN(SP_M1);
                { FRESH(C1); m2_gla_scan(P, C1); }
                GROUP_ARRIVE();
                { FRESH(C1); m1_conv(P, l, 32 * C.grp + 4 * (C.rk & 7) + (C.rk >> 3), C1); }
                { FRESH(C1); m1_pool(P, l, 32 * C.grp + 4 * (C.rk & 7) + (C.rk >> 3), C1); }
                GROUP_WAIT(); SPAN(SP_M2);
                { FRESH(C1); zero_rss(ws_rss(P, 0), C1); }
                { FRESH(C1); m3_gla_c(P, l, C1); }
                PANEL_BAR(); SPAN(SP_M3);
            }
            { FRESH(C1); ph_gemm(P, l, s, C1); }
            if (s == 0) GROUP_BAR();
            else if (l + 1 < DEPTH || s != 3) PANEL_BAR();
            SPAN(s == 0 ? SP_GEMM_IN : s == 1 ? SP_GEMM_OUT : s == 2 ? SP_GEMM_GU : SP_GEMM_DN);
        }
    }
#if SPAN_SEL
    if (C.tid == 0) { const unsigned long long t0 = __builtin_amdgcn_s_memrealtime(), w = SPW[1]; while (__builtin_amdgcn_s_memrealtime() - t0 < w) __builtin_amdgcn_s_sleep(32); }
#endif
}

extern "C" void kernel_launch(void* const* d_in, const int* in_sizes, int n_in, void* d_out, int out_size, void* d_ws, size_t ws_size, hipStream_t stream) {
    static int grid = 0;
    if (grid == 0) {
        if (n_in != 16 || in_sizes[0] != MTOK * D_MODEL || out_size != MTOK * D_MODEL || ws_size < WS_END) {
            fprintf(stderr, "kernel_launch: unexpected shapes / workspace: n_in %d in0 %d out %d ws %zu (need %zu); nothing launched\n", n_in, n_in > 0 ? in_sizes[0] : -1, out_size, ws_size, (size_t)WS_END); grid = -1; return; }
        int dev = 0, cus = 0, per_cu = 0;
        if (hipGetDevice(&dev) != hipSuccess || hipDeviceGetAttribute(&cus, hipDeviceAttributeMultiprocessorCount, dev) != hipSuccess) { fprintf(stderr, "kernel_launch: device query failed\n"); grid = -1; return; }
        if (hipFuncSetAttribute((const void*)mk_fwd, hipFuncAttributeMaxDynamicSharedMemorySize, LDS_BYTES) != hipSuccess) { fprintf(stderr, "kernel_launch: hipFuncSetAttribute failed\n"); grid = -1; return; }
        if (hipOccupancyMaxActiveBlocksPerMultiprocessor(&per_cu, (const void*)mk_fwd, 512, LDS_BYTES) != hipSuccess || per_cu < 1) { fprintf(stderr, "kernel_launch: occupancy query says %d blocks per CU\n", per_cu); (void)hipGetLastError(); }
        grid = cus;
        if (grid != 256) { fprintf(stderr, "kernel_launch: built for 256 CUs (8 groups of 32 workgroups), device has %d; nothing launched\n", cus); grid = -1; return; }
    }
    if (grid < 0) return;
    if (hipMemsetAsync((char*)d_ws + WS_CTL, 0, CTL_BYTES, stream) != hipSuccess) { fprintf(stderr, "kernel_launch: memset failed\n"); return; }
    Params P{};
    P.x = (const float*)d_in[0]; P.norm1_g = (const float*)d_in[1]; P.w_in = (const float*)d_in[2]; P.conv_w = (const float*)d_in[3]; P.sb_q_g = (const float*)d_in[4]; P.sb_k_g = (const float*)d_in[5];
    P.gla_a_w = (const float*)d_in[6]; P.gla_a_b = (const float*)d_in[7]; P.gla_norm_g = (const float*)d_in[8]; P.pool_w = (const float*)d_in[9]; P.pool_scale = (const float*)d_in[10];
    P.w_out = (const float*)d_in[11]; P.norm2_g = (const float*)d_in[12]; P.w_gate = (const float*)d_in[13]; P.w_up = (const float*)d_in[14]; P.w_down = (const float*)d_in[15];
    P.out = (float*)d_out; P.ws = (unsigned char*)d_ws;
    hipLaunchKernelGGL(mk_fwd, dim3(grid), dim3(512), LDS_BYTES, stream, P);
    const hipError_t le = hipPeekAtLastError();
    if (le != hipSuccess) fprintf(stderr, "kernel_launch: launch failed: %s\n", hipGetErrorName(le));
}
```
